# Optimizing an MI355X kernel written in HIP

```python
import math
import jax, jax.numpy as jnp
from jax import lax
import numpy as np

D_MODEL = 2048
BATCH = 4
SEQ = 8192
DEPTH = 1

CHUNK = 64
Q_BLOCK = 128
SSM_WIDTH = D_MODEL // 2
SSM_GROUP = 16
SSM_GROUPS = SSM_WIDTH // SSM_GROUP
SSM_STATE = 64
ATTN_WIDTH = D_MODEL - SSM_WIDTH
ATTN_HEADS = 8
ATTN_V_DIM = ATTN_WIDTH // ATTN_HEADS
ATTN_QK_DIM = ATTN_V_DIM // 2
IN_WIDTH = SSM_WIDTH + 3 * ATTN_WIDTH
MLP_HIDDEN = 4 * D_MODEL
RMS_EPS = 1e-6
DT_MIN = 0.001
DT_MAX = 0.1

kernel_name = "hybrid_s5_diffattn_adaln_block"


def _rms_f32(x, g):
    xf = x.astype(jnp.float32)
    return xf * lax.rsqrt(jnp.mean(xf * xf, axis=-1, keepdims=True) + RMS_EPS) * g.astype(jnp.float32)


def _rmsnorm(x, g):
    return _rms_f32(x, g).astype(x.dtype)


def _s5_combine(e1, e2):
    a1r, a1i, b1r, b1i = e1
    a2r, a2i, b2r, b2i = e2
    return (a2r * a1r - a2i * a1i,
            a2r * a1i + a2i * a1r,
            a2r * b1r - a2i * b1i + b2r,
            a2r * b1i + a2i * b1r + b2i)


def _s5_mixer(u, lam_re, lam_im, b_re, b_im, c_re, c_im, d, log_step, w_glu, b_glu):
    f32 = jnp.float32
    bsz, seq, _ = u.shape
    n_chunks = seq // CHUNK
    u4 = u.astype(f32).reshape(bsz, seq, SSM_GROUPS, SSM_GROUP)
    lr = lam_re.astype(f32)
    li = lam_im.astype(f32)
    dt = jnp.exp(log_step.astype(f32))[:, None]
    mag = jnp.exp(dt * lr)
    ar = mag * jnp.cos(dt * li)
    ai = mag * jnp.sin(dt * li)
    den = lr * lr + li * li
    zr = ar - 1.0
    kr = (zr * lr + ai * li) / den
    ki = (ai * lr - zr * li) / den
    br = b_re.astype(f32)
    bi = b_im.astype(f32)
    bbar_r = kr[..., None] * br - ki[..., None] * bi
    bbar_i = kr[..., None] * bi + ki[..., None] * br
    steps = jnp.arange(1, CHUNK + 1, dtype=f32)[:, None, None]
    pmag = jnp.exp(steps * dt * lr)
    pw_r = pmag * jnp.cos(steps * dt * li)
    pw_i = pmag * jnp.sin(steps * dt * li)
    a_r = jnp.broadcast_to(ar, (bsz, CHUNK, SSM_GROUPS, SSM_STATE))
    a_i = jnp.broadcast_to(ai, (bsz, CHUNK, SSM_GROUPS, SSM_STATE))
    cr = c_re.astype(f32)
    ci = c_im.astype(f32)
    u_chunks = u4.reshape(bsz, n_chunks, CHUNK, SSM_GROUPS, SSM_GROUP).transpose(1, 0, 2, 3, 4)

    def step(carry, uc):
        hr0, hi0 = carry
        bu_r = jnp.einsum('bsgh,gph->bsgp', uc, bbar_r)
        bu_i = jnp.einsum('bsgh,gph->bsgp', uc, bbar_i)
        _, _, loc_r, loc_i = lax.associative_scan(_s5_combine, (a_r, a_i, bu_r, bu_i), axis=1)
        hr = loc_r + pw_r * hr0[:, None] - pw_i * hi0[:, None]
        hi = loc_i + pw_r * hi0[:, None] + pw_i * hr0[:, None]
        y = jnp.einsum('gqp,bsgp->bsgq', cr, hr) - jnp.einsum('gqp,bsgp->bsgq', ci, hi)
        return (hr[:, -1], hi[:, -1]), y

    init = (jnp.zeros((bsz, SSM_GROUPS, SSM_STATE), f32), jnp.zeros((bsz, SSM_GROUPS, SSM_STATE), f32))
    _, ys = lax.scan(step, init, u_chunks)
    y = ys.transpose(1, 0, 2, 3, 4).reshape(bsz, seq, SSM_GROUPS, SSM_GROUP) + d.astype(f32) * u4
    y = jax.nn.gelu(y.reshape(bsz, seq, SSM_WIDTH), approximate=False).astype(u.dtype)
    return y * jax.nn.sigmoid(y @ w_glu + b_glu)


def _diff_attention(q, k, v, g_q, g_k, lq1, lk1, lq2, lk2, g_subln, lambda_init):
    f32 = jnp.float32
    out_dtype = v.dtype
    bsz, seq, _ = q.shape
    q = _rms_f32(q.reshape(bsz, seq, ATTN_HEADS, 2, ATTN_QK_DIM), g_q) * (ATTN_QK_DIM ** -0.5)
    k = _rms_f32(k.reshape(bsz, seq, ATTN_HEADS, 2, ATTN_QK_DIM), g_k)
    v = v.reshape(bsz, seq, ATTN_HEADS, ATTN_V_DIM).astype(f32)
    lam = (jnp.exp(jnp.sum(lq1.astype(f32) * lk1.astype(f32)))
           - jnp.exp(jnp.sum(lq2.astype(f32) * lk2.astype(f32))) + lambda_init)
    n_blocks = seq // Q_BLOCK
    qb = q.reshape(bsz, n_blocks, Q_BLOCK, ATTN_HEADS, 2, ATTN_QK_DIM).transpose(1, 0, 2, 3, 4, 5)
    k_chunk = jnp.arange(seq) // CHUNK

    def block(args):
        qblk, idx = args
        s = jnp.einsum('bqhcd,bkhcd->bhcqk', qblk, k)
        q_chunk = (idx * Q_BLOCK + jnp.arange(Q_BLOCK)) // CHUNK
        mask = k_chunk[None, :] <= q_chunk[:, None]
        p = jax.nn.softmax(jnp.where(mask, s, -jnp.inf), axis=-1)
        w = p[:, :, 0] - lam * p[:, :, 1]
        return jnp.einsum('bhqk,bkhe->bqhe', w, v)

    o = lax.map(block, (qb, jnp.arange(n_blocks)))
    o = o.transpose(1, 0, 2, 3, 4).reshape(bsz, seq, ATTN_HEADS, ATTN_V_DIM)
    o = _rms_f32(o, g_subln) * (1.0 - lambda_init)
    return o.reshape(bsz, seq, ATTN_WIDTH).astype(out_dtype)


def setup_inputs(seed: int = 0) -> dict:
    key = jax.random.key(seed)
    ks = jax.random.split(key, 32)
    f32 = jnp.float32

    def nrm(k, shape, scale):
        return jax.random.normal(k, shape, f32) * scale

    G, P, H = SSM_GROUPS, SSM_STATE, SSM_GROUP
    n_idx = jnp.arange(P, dtype=f32)
    return {
        "x": nrm(ks[0], (BATCH, SEQ, D_MODEL), 1.0),
        "c": nrm(ks[1], (BATCH, D_MODEL), 1.0),
        "w_ada": nrm(ks[2], (DEPTH, D_MODEL, 6 * D_MODEL), 0.5 * D_MODEL ** -0.5),
        "b_ada": nrm(ks[3], (DEPTH, 6 * D_MODEL), 0.02),
        "g_norm_mix": 1.0 + nrm(ks[4], (DEPTH, D_MODEL), 0.02),
        "g_norm_mlp": 1.0 + nrm(ks[5], (DEPTH, D_MODEL), 0.02),
        "w_in": nrm(ks[6], (DEPTH, D_MODEL, IN_WIDTH), D_MODEL ** -0.5),
        "ssm_lambda_re": -0.5 * jnp.exp(nrm(ks[7], (DEPTH, G, P), 0.05)),
        "ssm_lambda_im": jnp.pi * n_idx + nrm(ks[8], (DEPTH, G, P), 0.01),
        "ssm_b_re": nrm(ks[9], (DEPTH, G, P, H), (2 * H) ** -0.5),
        "ssm_b_im": nrm(ks[10], (DEPTH, G, P, H), (2 * H) ** -0.5),
        "ssm_c_re": nrm(ks[11], (DEPTH, G, H, P), P ** -0.5),
        "ssm_c_im": nrm(ks[12], (DEPTH, G, H, P), P ** -0.5),
        "ssm_d": nrm(ks[13], (DEPTH, G, H), 1.0),
        "ssm_log_step": jax.random.uniform(ks[14], (DEPTH, G), f32, math.log(DT_MIN), math.log(DT_MAX)),
        "w_glu": nrm(ks[15], (DEPTH, SSM_WIDTH, SSM_WIDTH), SSM_WIDTH ** -0.5),
        "b_glu": nrm(ks[16], (DEPTH, SSM_WIDTH), 0.02),
        "g_q": 1.0 + nrm(ks[17], (DEPTH, ATTN_QK_DIM), 0.02),
        "g_k": 1.0 + nrm(ks[18], (DEPTH, ATTN_QK_DIM), 0.02),
        "lambda_q1": nrm(ks[19], (DEPTH, ATTN_QK_DIM), 0.1),
        "lambda_k1": nrm(ks[20], (DEPTH, ATTN_QK_DIM), 0.1),
        "lambda_q2": nrm(ks[21], (DEPTH, ATTN_QK_DIM), 0.1),
        "lambda_k2": nrm(ks[22], (DEPTH, ATTN_QK_DIM), 0.1),
        "g_subln": 1.0 + nrm(ks[23], (DEPTH, ATTN_V_DIM), 0.02),
        "w_out": nrm(ks[24], (DEPTH, D_MODEL, D_MODEL), D_MODEL ** -0.5),
        "w_mlp1": nrm(ks[25], (DEPTH, D_MODEL, MLP_HIDDEN), D_MODEL ** -0.5),
        "w_mlp2": nrm(ks[26], (DEPTH, MLP_HIDDEN, D_MODEL), MLP_HIDDEN ** -0.5),
    }


def reference(x, c, w_ada, b_ada, g_norm_mix, g_norm_mlp, w_in, ssm_lambda_re, ssm_lambda_im,
              ssm_b_re, ssm_b_im, ssm_c_re, ssm_c_im, ssm_d, ssm_log_step, w_glu, b_glu,
              g_q, g_k, lambda_q1, lambda_k1, lambda_q2, lambda_k2, g_subln, w_out, w_mlp1, w_mlp2):
    c_act = jax.nn.silu(c)
    for l in range(DEPTH):
        lambda_init = 0.8 - 0.6 * math.exp(-0.3 * l)
        mod = c_act @ w_ada[l] + b_ada[l]
        shift1, scale1, gate1, shift2, scale2, gate2 = jnp.split(mod, 6, axis=-1)
        h = _rmsnorm(x, g_norm_mix[l]) * (1.0 + scale1[:, None]) + shift1[:, None]
        proj = h @ w_in[l]
        u, q, k, v = jnp.split(proj, [SSM_WIDTH, SSM_WIDTH + ATTN_WIDTH, SSM_WIDTH + 2 * ATTN_WIDTH], axis=-1)
        y_ssm = _s5_mixer(u, ssm_lambda_re[l], ssm_lambda_im[l], ssm_b_re[l], ssm_b_im[l],
                          ssm_c_re[l], ssm_c_im[l], ssm_d[l], ssm_log_step[l], w_glu[l], b_glu[l])
        y_att = _diff_attention(q, k, v, g_q[l], g_k[l], lambda_q1[l], lambda_k1[l],
                                lambda_q2[l], lambda_k2[l], g_subln[l], lambda_init)
        mixed = jnp.concatenate([y_ssm, y_att], axis=-1) @ w_out[l]
        x = x + gate1[:, None] * mixed
        h = _rmsnorm(x, g_norm_mlp[l]) * (1.0 + scale2[:, None]) + shift2[:, None]
        x = x + gate2[:, None] * (jnp.square(jax.nn.relu(h @ w_mlp1[l])) @ w_mlp2[l])
    return x
```

```cpp
#include <hip/hip_runtime.h>
#include <hip/hip_cooperative_groups.h>
#include <cstdio>
#include <cstdint>
#include <cmath>
namespace cg = cooperative_groups;

#define LAS __attribute__((address_space(3)))
typedef unsigned short bf16_t;
typedef short bf16x8 __attribute__((ext_vector_type(8)));
typedef short s16x4 __attribute__((ext_vector_type(4)));
typedef float f32x4 __attribute__((ext_vector_type(4)));
typedef float f32x16 __attribute__((ext_vector_type(16)));
typedef unsigned u32x4 __attribute__((ext_vector_type(4)));
typedef unsigned u32x2 __attribute__((ext_vector_type(2)));

constexpr int NB = 4, SEQ = 8192, DM = 2048, MTOK = NB * SEQ;
constexpr int SSMW = 1024, ATW = 1024, INW = 4096, HID = 8192;
constexpr int NG = 64, NP = 64;
constexpr float RMS_EPS = 1e-6f;
constexpr float LAMBDA_INIT = 0.2f;
constexpr float QSCALE = 0.125f * 1.4426950408889634f;

constexpr size_t MiB = 1u << 20;
constexpr size_t WS_ACT = 0;
constexpr size_t WS_UG = 0;
constexpr size_t WS_Q = 64 * MiB;
constexpr size_t WS_K = 128 * MiB;
constexpr size_t WS_V = 192 * MiB;
constexpr size_t WS_YS = 256 * MiB;
constexpr size_t WS_CAT = 320 * MiB;
constexpr size_t WS_H = 512 * MiB;
constexpr size_t WS_WIN = 640 * MiB;
constexpr size_t WS_WGLU = 656 * MiB;
constexpr size_t WS_WOUT = 658 * MiB;
constexpr size_t WS_W1 = 666 * MiB;
constexpr size_t WS_W2 = 698 * MiB;
constexpr size_t WS_MOD = 730 * MiB;
constexpr size_t WS_RSS = 730 * MiB + 256 * 1024;
constexpr size_t WS_AV = 731 * MiB;
constexpr size_t WS_A1K = 731 * MiB + 32 * 1024;
constexpr size_t WS_BB = 731 * MiB + 64 * 1024;
constexpr size_t WS_CM = 731 * MiB + 320 * 1024;
constexpr size_t WS_B2 = 731 * MiB + 640 * 1024;
constexpr size_t WS_CTL = 731 * MiB + 832 * 1024;
constexpr size_t CTL_BYTES = 16384;
constexpr size_t WS_END = 732 * MiB;

constexpr int LDS_BYTES = 147456;

__device__ __forceinline__ unsigned cvt_pk_bf16(float lo, float hi) { unsigned r; asm volatile("v_cvt_pk_bf16_f32 %0, %1, %2" : "=v"(r) : "v"(lo), "v"(hi)); return r; }
__device__ __forceinline__ float bf2f(unsigned short v) { return __uint_as_float((unsigned)v << 16); }
__device__ __forceinline__ float bflo(unsigned v) { return __uint_as_float(v << 16); }
__device__ __forceinline__ float bfhi(unsigned v) { return __uint_as_float(v & 0xffff0000u); }
__device__ __forceinline__ unsigned short f2bf(float f) { return (unsigned short)(cvt_pk_bf16(f, 0.f) & 0xffffu); }
__device__ __forceinline__ float gelu_f(float v) {
    const float av = fabsf(v), t = __builtin_amdgcn_rcpf(av * 0.2316418882f + 1.0f);
    float q = t * 0.5307027145f + (-0.7265760135f); q = q * t + 0.7107068705f; q = q * t + (-0.142248368f); q = q * t + 0.127414796f; q = q * t;
    const float e = __builtin_amdgcn_exp2f((v * v) * (-0.72134752044f));
    const float m = v * (q * e);
    return v < 0.f ? m : v - m;
}
__device__ __forceinline__ float wave_sum(float v) {
#pragma unroll
    for (int o = 1; o < 64; o <<= 1) v += __shfl_xor(v, o);
    return v;
}

namespace pg8 {
constexpr int BM = 256, BK = 64, HALF = 128, HTB = HALF * BK * 2, STAGE_BYTES = 8 * HTB, NXCD = 8;
__host__ __device__ __forceinline__ int lds_byte(int r, int c) { const int st = (r >> 4) * 2 + (c >> 5), rr = r & 15, cc = c & 31, ob = rr * 64 + cc * 2; return st * 1024 + (ob ^ (((ob >> 9) & 1) << 5)); }
__host__ __device__ __forceinline__ void stage_rc(int b, int& R, int& C) { const int st = b / 1024, sb = b % 1024, swz = sb ^ (((sb >> 9) & 1) << 5); R = (st >> 1) * 16 + swz / 64; C = (st & 1) * 32 + (swz % 64) / 2; }
__host__ __device__ __forceinline__ int perm32(int rho) { const int n = rho >> 4, i = rho & 15; return 8 * (i >> 2) + 4 * n + (i & 3); }

struct Unit { int pm, pn; };
struct Gemm { const bf16_t* A; const bf16_t* Bt; int M, N, K; };

struct StaticOrder {
    int nM, nN, nwg, G, c, WGM;
    __device__ void init(int M, int N, int G_, int c_, int wgm) { nM = M / BM; nN = N / BM; nwg = nM * nN; G = G_; c = c_; WGM = wgm; }
    __device__ bool next(int i, Unit& u) const {
        const long L = (long)i * G + c; if (L >= nwg) return false;
        int wgid = (int)L; { const int q = nwg / NXCD, r = nwg % NXCD, xcd = wgid % NXCD, off = wgid / NXCD; wgid = (xcd < r ? xcd * (q + 1) : r * (q + 1) + (xcd - r) * q) + off; }
        const int nig = WGM * nN, gid = wgid / nig, fm = gid * WGM, gsz = (nM - fm) < WGM ? (nM - fm) : WGM;
        u.pm = fm + ((wgid % nig) % gsz); u.pn = (wgid % nig) / gsz; return true;
    }
};

template <class Epi>
__device__ __forceinline__ void gemm_phase(LAS unsigned char* lds, const Gemm g, const StaticOrder& S, const Epi& E) {
    const int tid = threadIdx.x, wid = __builtin_amdgcn_readfirstlane(tid >> 6), lane = tid & 63, wr = wid >> 2, wc = wid & 3, fr = lane & 15, fq = lane >> 4;
    const int K = g.K, nt = K / BK;
    unsigned voffA[2], voffB[2];
#pragma unroll
    for (int i = 0; i < 2; ++i) { int R, C; stage_rc(tid * 16 + i * 8192, R, C);
        const int Rb = (Epi::BMODE == 2) ? (64 * (R >> 5) + perm32(R & 31)) : R;
        voffA[i] = (unsigned)(R * K + C) * 2u; voffB[i] = (unsigned)(Rb * K + C) * 2u; }
    const size_t kstep = (size_t)(BK * 2);
    const size_t hstep = (size_t)HALF * K * 2;
    const size_t hstepB = (Epi::BMODE == 2) ? (size_t)32 * K * 2 : hstep;
    const size_t tstep = 2 * hstep;
    const unsigned ldsw = (unsigned)wid * 1024u;
    const int aoff = lds_byte(wr * 64 + fr, fq * 8), boff = lds_byte(wc * 32 + fr, fq * 8);
#define PG8_SA(b, h) (((b) * 2 + (h)) * HTB)
#define PG8_SB(b, h) ((4 + (b) * 2 + (h)) * HTB)
#define PG8_STAGE(bufoff, gbase, voff) do { _Pragma("unroll") for (int _i = 0; _i < 2; ++_i) \
        __builtin_amdgcn_global_load_lds((const unsigned*)((const char*)(gbase) + (voff)[_i]), (LAS unsigned*)(lds + (bufoff) + ldsw + _i * 8192), 16, 0, 0); } while (0)
#define PG8_LDA(dst, b, h) do { _Pragma("unroll") for (int m = 0; m < 4; ++m) _Pragma("unroll") for (int k = 0; k < 2; ++k) dst[m][k] = *(const LAS bf16x8*)(lds + PG8_SA(b, h) + aoff + m * 2048 + k * 1024); } while (0)
#define PG8_LDB(dst, b, h) do { _Pragma("unroll") for (int n = 0; n < 2; ++n) _Pragma("unroll") for (int k = 0; k < 2; ++k) dst[n][k] = *(const LAS bf16x8*)(lds + PG8_SB(b, h) + boff + n * 2048 + k * 1024); } while (0)
#define PG8_MMA(ai, bj, At, Bt) do { __builtin_amdgcn_s_setprio(1); _Pragma("unroll") for (int m = 0; m < 4; ++m) _Pragma("unroll") for (int n = 0; n < 2; ++n) _Pragma("unroll") for (int k = 0; k < 2; ++k) \
        acc[ai][bj][m][n] = __builtin_amdgcn_mfma_f32_16x16x32_bf16(Bt[n][k], At[m][k], acc[ai][bj][m][n], 0, 0, 0); __builtin_amdgcn_s_setprio(0); } while (0)
#define PG8_WAIT_V(n) asm volatile("s_waitcnt vmcnt(" #n ")" ::: "memory")
#define PG8_WAIT_L(n) asm volatile("s_waitcnt lgkmcnt(" #n ")" ::: "memory")
#define PG8_BAR __builtin_amdgcn_s_barrier()
#define PG8_SCHED __builtin_amdgcn_sched_barrier(0)
    Unit cur, nxt; int ui = 0;
    if (!S.next(0, cur)) return;
    f32x4 acc[2][2][4][2];
#pragma unroll
    for (int a = 0; a < 2; ++a)
#pragma unroll
        for (int b = 0; b < 2; ++b)
#pragma unroll
            for (int m = 0; m < 4; ++m)
#pragma unroll
                for (int n = 0; n < 2; ++n) acc[a][b][m][n] = (f32x4){0.f, 0.f, 0.f, 0.f};
    bf16x8 At[4][2], B0[2][2], B1[2][2];
    const char* cA = (const char*)g.A + (size_t)cur.pm * tstep; const char* cB = (const char*)g.Bt + (size_t)cur.pn * tstep;
    PG8_STAGE(PG8_SB(0, 0), cB, voffB); PG8_STAGE(PG8_SB(0, 1), cB + hstepB, voffB); PG8_STAGE(PG8_SA(0, 0), cA, voffA); PG8_STAGE(PG8_SA(0, 1), cA + hstep, voffA);
    if (wr == 1) PG8_BAR;
    PG8_WAIT_V(2); PG8_BAR;
    PG8_STAGE(PG8_SB(1, 0), cB + kstep, voffB); PG8_STAGE(PG8_SA(1, 0), cA + kstep, voffA); PG8_STAGE(PG8_SB(1, 1), cB + hstepB + kstep, voffB);
    PG8_WAIT_V(6); PG8_BAR;
    for (;;) {
        const bool has_next = S.next(ui + 1, nxt);
        const char* nA = has_next ? (const char*)g.A + (size_t)nxt.pm * tstep : cA; const char* nB = has_next ? (const char*)g.Bt + (size_t)nxt.pn * tstep : cB;
        for (int t = 0; t < nt; t += 2) {
            const bool last = (t == nt - 2);
            const char* a1 = cA + (size_t)(t + 1) * kstep;
            const char* a2 = last ? nA : cA + (size_t)(t + 2) * kstep; const char* b2 = last ? nB : cB + (size_t)(t + 2) * kstep;
            const char* a3 = a2 + kstep; const char* b3 = b2 + kstep;
            PG8_LDB(B0, 0, 0); PG8_LDB(B1, 0, 1); PG8_SCHED; PG8_LDA(At, 0, 0); PG8_STAGE(PG8_SA(1, 1), a1 + hstep, voffA);
            PG8_WAIT_V(8); PG8_WAIT_L(0); PG8_BAR; PG8_MMA(0, 0, At, B0); PG8_MMA(0, 1, At, B1); PG8_BAR; PG8_SCHED;
            PG8_LDA(At, 0, 1); PG8_STAGE(PG8_SB(0, 0), b2, voffB); PG8_STAGE(PG8_SB(0, 1), b2 + hstepB, voffB); PG8_STAGE(PG8_SA(0, 0), a2, voffA);
            PG8_WAIT_V(8); PG8_WAIT_L(0); PG8_BAR; PG8_MMA(1, 0, At, B0); PG8_MMA(1, 1, At, B1); PG8_BAR; PG8_SCHED;
            PG8_LDB(B0, 1, 0); PG8_LDB(B1, 1, 1); PG8_SCHED; PG8_LDA(At, 1, 0); PG8_STAGE(PG8_SA(0, 1), a2 + hstep, voffA);
            PG8_WAIT_V(8); PG8_WAIT_L(0); PG8_BAR; PG8_MMA(0, 0, At, B0); PG8_MMA(0, 1, At, B1); PG8_BAR; PG8_SCHED;
            PG8_LDA(At, 1, 1); PG8_STAGE(PG8_SB(1, 0), b3, voffB); PG8_STAGE(PG8_SB(1, 1), b3 + hstepB, voffB); PG8_STAGE(PG8_SA(1, 0), a3, voffA);
            PG8_WAIT_V(8); PG8_WAIT_L(0); PG8_BAR; PG8_MMA(1, 0, At, B0); PG8_MMA(1, 1, At, B1); PG8_BAR; PG8_SCHED;
        }
        if (wr == 0) PG8_BAR;
        E(acc, cur, wr, wc, fr, fq);
        if (!has_next) break;
#pragma unroll
        for (int a = 0; a < 2; ++a)
#pragma unroll
            for (int b = 0; b < 2; ++b)
#pragma unroll
                for (int m = 0; m < 4; ++m)
#pragma unroll
                    for (int n = 0; n < 2; ++n) acc[a][b][m][n] = (f32x4){0.f, 0.f, 0.f, 0.f};
        cur = nxt; cA = nA; cB = nB; ++ui;
        if (wr == 1) PG8_BAR;
    }
    PG8_WAIT_V(0);
    PG8_BAR;
#undef PG8_SA
#undef PG8_SB
#undef PG8_STAGE
#undef PG8_LDA
#undef PG8_LDB
#undef PG8_MMA
#undef PG8_WAIT_V
#undef PG8_WAIT_L
#undef PG8_BAR
#undef PG8_SCHED
}
}

struct EpiInProj {
    static constexpr int BMODE = 2;
    bf16_t *UG, *Q, *Kb, *V; const float *gq, *gk;
    __device__ __forceinline__ void operator()(const f32x4 (&acc)[2][2][4][2], const pg8::Unit& u, int wr, int wc, int fr, int fq) const {
        const int sec = u.pn >> 2, cs0 = (u.pn & 3) * 256 + 64 * wc + 8 * fq;
        const int row0 = u.pm * 256 + wr * 64 + fr;
        if (sec == 1 || sec == 2) {
            const float* gv = (sec == 1) ? gq : gk; const float sc = (sec == 1) ? QSCALE : 1.0f;
            bf16_t* O = (sec == 1) ? Q : Kb;
            f32x4 g4[2][2];
#pragma unroll
            for (int bj = 0; bj < 2; ++bj)
#pragma unroll
                for (int n = 0; n < 2; ++n) g4[bj][n] = *(const f32x4*)(gv + 32 * bj + 8 * fq + 4 * n) * sc;
#pragma unroll
            for (int ai = 0; ai < 2; ++ai)
#pragma unroll
                for (int m = 0; m < 4; ++m) {
                    float ss = 0.f;
#pragma unroll
                    for (int bj = 0; bj < 2; ++bj)
#pragma unroll
                        for (int n = 0; n < 2; ++n) { const f32x4 v = acc[ai][bj][m][n]; ss += (v[0] * v[0] + v[1] * v[1]) + (v[2] * v[2] + v[3] * v[3]); }
                    ss += __shfl_xor(ss, 16); ss += __shfl_xor(ss, 32);
                    const float rs = __builtin_amdgcn_rsqf(ss * (1.0f / 64.0f) + RMS_EPS);
                    bf16_t* rowp = O + (size_t)(row0 + ai * 128 + m * 16) * 1024 + cs0;
#pragma unroll
                    for (int bj = 0; bj < 2; ++bj) { const f32x4 v0 = acc[ai][bj][m][0] * rs * g4[bj][0], v1 = acc[ai][bj][m][1] * rs * g4[bj][1];
                        u32x4 w; w.x = cvt_pk_bf16(v0[0], v0[1]); w.y = cvt_pk_bf16(v0[2], v0[3]); w.z = cvt_pk_bf16(v1[0], v1[1]); w.w = cvt_pk_bf16(v1[2], v1[3]);
                        *(u32x4*)(rowp + bj * 32) = w; }
                }
        } else {
#pragma unroll
            for (int ai = 0; ai < 2; ++ai)
#pragma unroll
                for (int m = 0; m < 4; ++m) { const int row = row0 + ai * 128 + m * 16;
#pragma unroll
                    for (int bj = 0; bj < 2; ++bj) { const f32x4 v0 = acc[ai][bj][m][0], v1 = acc[ai][bj][m][1];
                        u32x4 w; w.x = cvt_pk_bf16(v0[0], v0[1]); w.y = cvt_pk_bf16(v0[2], v0[3]); w.z = cvt_pk_bf16(v1[0], v1[1]); w.w = cvt_pk_bf16(v1[2], v1[3]);
                        const int cs = cs0 + 32 * bj;
                        if (sec == 0) { const int b = row >> 13, t = row & 8191, gg = cs >> 4, j0 = cs & 15;
                            *(u32x4*)(UG + ((size_t)(b * NG + gg) * SEQ + t) * 16 + j0) = w; }
                        else *(u32x4*)(V + (size_t)row * 1024 + cs) = w; } }
        }
    }
};
struct EpiGlu {
    static constexpr int BMODE = 2;
    const bf16_t* Y; bf16_t* CAT; const float* bias;
    __device__ __forceinline__ void operator()(const f32x4 (&acc)[2][2][4][2], const pg8::Unit& u, int wr, int wc, int fr, int fq) const {
        const int c0 = u.pn * 256 + 64 * wc + 8 * fq, row0 = u.pm * 256 + wr * 64 + fr;
        f32x4 b4[2][2];
#pragma unroll
        for (int bj = 0; bj < 2; ++bj)
#pragma unroll
            for (int n = 0; n < 2; ++n) b4[bj][n] = *(const f32x4*)(bias + c0 + 32 * bj + 4 * n);
#pragma unroll
        for (int ai = 0; ai < 2; ++ai)
#pragma unroll
            for (int m = 0; m < 4; ++m) { const size_t row = (size_t)(row0 + ai * 128 + m * 16);
#pragma unroll
                for (int bj = 0; bj < 2; ++bj) { const int c = c0 + 32 * bj;
                    const u32x4 yv = *(const u32x4*)(Y + row * 1024 + c);
                    const f32x4 a0 = acc[ai][bj][m][0] + b4[bj][0], a1 = acc[ai][bj][m][1] + b4[bj][1];
                    float y[8] = {bflo(yv.x), bfhi(yv.x), bflo(yv.y), bfhi(yv.y), bflo(yv.z), bfhi(yv.z), bflo(yv.w), bfhi(yv.w)};
                    float z[8];
#pragma unroll
                    for (int j = 0; j < 8; ++j) { const float a = j < 4 ? a0[j & 3] : a1[j & 3]; z[j] = y[j] * __builtin_amdgcn_rcpf(1.0f + __builtin_amdgcn_exp2f(-1.4426950408889634f * a)); }
                    u32x4 w; w.x = cvt_pk_bf16(z[0], z[1]); w.y = cvt_pk_bf16(z[2], z[3]); w.z = cvt_pk_bf16(z[4], z[5]); w.w = cvt_pk_bf16(z[6], z[7]);
                    *(u32x4*)(CAT + row * 2048 + c) = w; } }
    }
};
struct EpiMlp1 {
    static constexpr int BMODE = 2;
    bf16_t* ACT; const float* rss; const float* bias2;
    __device__ __forceinline__ void operator()(const f32x4 (&acc)[2][2][4][2], const pg8::Unit& u, int wr, int wc, int fr, int fq) const {
        const int c0 = u.pn * 256 + 64 * wc + 8 * fq, row0 = u.pm * 256 + wr * 64 + fr;
        const int b = (u.pm * 256) >> 13;
        f32x4 b4[2][2];
#pragma unroll
        for (int bj = 0; bj < 2; ++bj)
#pragma unroll
            for (int n = 0; n < 2; ++n) b4[bj][n] = *(const f32x4*)(bias2 + (size_t)b * HID + c0 + 32 * bj + 4 * n);
#pragma unroll
        for (int ai = 0; ai < 2; ++ai)
#pragma unroll
            for (int m = 0; m < 4; ++m) { const int row = row0 + ai * 128 + m * 16; bf16_t* rowp = ACT + (size_t)row * HID + c0;
                const float rs = __builtin_amdgcn_rsqf(rss[row] * (1.0f / DM) + RMS_EPS);
#pragma unroll
                for (int bj = 0; bj < 2; ++bj) { f32x4 v0 = acc[ai][bj][m][0] * rs + b4[bj][0], v1 = acc[ai][bj][m][1] * rs + b4[bj][1];
#pragma unroll
                    for (int j = 0; j < 4; ++j) { const float a = fmaxf(v0[j], 0.f), bq = fmaxf(v1[j], 0.f); v0[j] = a * a; v1[j] = bq * bq; }
                    u32x4 w; w.x = cvt_pk_bf16(v0[0], v0[1]); w.y = cvt_pk_bf16(v0[2], v0[3]); w.z = cvt_pk_bf16(v1[0], v1[1]); w.w = cvt_pk_bf16(v1[2], v1[3]);
                    __builtin_nontemporal_store(w, (u32x4*)(rowp + bj * 32)); } }
    }
};
template <bool RSS> struct EpiResid {
    static constexpr int BMODE = 2;
    const float* base; float* out; const float* gate; float* rss; const float* gnorm; const float* scale; bf16_t* H;
    __device__ __forceinline__ void operator()(const f32x4 (&acc)[2][2][4][2], const pg8::Unit& u, int wr, int wc, int fr, int fq) const {
        const int c0 = u.pn * 256 + 64 * wc + 8 * fq, row0 = u.pm * 256 + wr * 64 + fr;
        const int b = (u.pm * 256) >> 13;
        f32x4 g4[2][2], s4[2][2];
#pragma unroll
        for (int bj = 0; bj < 2; ++bj)
#pragma unroll
            for (int n = 0; n < 2; ++n) { g4[bj][n] = *(const f32x4*)(gate + (size_t)b * 12288 + c0 + 32 * bj + 4 * n);
                if (RSS) s4[bj][n] = *(const f32x4*)(gnorm + c0 + 32 * bj + 4 * n) * (*(const f32x4*)(scale + (size_t)b * 12288 + c0 + 32 * bj + 4 * n) + 1.0f); }
#pragma unroll
        for (int ai = 0; ai < 2; ++ai)
#pragma unroll
            for (int m = 0; m < 4; ++m) { const int row = row0 + ai * 128 + m * 16; const size_t off = (size_t)row * DM + c0; float ss = 0.f;
#pragma unroll
                for (int bj = 0; bj < 2; ++bj) {
                    const f32x4 b0_ = RSS ? __builtin_nontemporal_load((const f32x4*)(base + off + 32 * bj)) : *(const f32x4*)(base + off + 32 * bj), b1_ = RSS ? __builtin_nontemporal_load((const f32x4*)(base + off + 32 * bj + 4)) : *(const f32x4*)(base + off + 32 * bj + 4);
                    const f32x4 o0 = b0_ + g4[bj][0] * acc[ai][bj][m][0], o1 = b1_ + g4[bj][1] * acc[ai][bj][m][1];
                    *(f32x4*)(out + off + 32 * bj) = o0; *(f32x4*)(out + off + 32 * bj + 4) = o1;
                    if (RSS) { ss += (o0[0] * o0[0] + o0[1] * o0[1]) + (o0[2] * o0[2] + o0[3] * o0[3]) + (o1[0] * o1[0] + o1[1] * o1[1]) + (o1[2] * o1[2] + o1[3] * o1[3]);
                        const f32x4 h0 = o0 * s4[bj][0], h1 = o1 * s4[bj][1];
                        u32x4 w; w.x = cvt_pk_bf16(h0[0], h0[1]); w.y = cvt_pk_bf16(h0[2], h0[3]); w.z = cvt_pk_bf16(h1[0], h1[1]); w.w = cvt_pk_bf16(h1[2], h1[3]);
                        *(u32x4*)(H + off + 32 * bj) = w; } }
                if (RSS) { ss += __shfl_xor(ss, 16); ss += __shfl_xor(ss, 32); if (fq == 0) atomicAdd(rss + row, ss); } }
    }
};

namespace att {
constexpr int SLOT = 32768, NSLOT = 4, OFF_V = 16384, RING = NSLOT * SLOT, OFF_WSF = RING, XPAIR = 17408;
__device__ __forceinline__ int crow(int r, int hi) { return (r & 3) + 8 * (r >> 2) + 4 * hi; }
__device__ __forceinline__ void glds16(const void* gsrc, unsigned lds_dst) { unsigned keep;
    asm volatile("s_mov_b32 %0, m0\n\ts_mov_b32 m0, %2\n\ts_nop 0\n\tglobal_load_lds_dwordx4 %1, off\n\ts_mov_b32 m0, %0" : "=&s"(keep) : "v"(gsrc), "s"(lds_dst) : "memory"); }
__device__ __forceinline__ s16x4 vtr(const LAS char* p) { return __builtin_bit_cast(s16x4, __builtin_amdgcn_ds_read_tr16_b64_v4i16((LAS s16x4*)p)); }
__device__ __forceinline__ float swap_max(float m) { auto rr = __builtin_amdgcn_permlane32_swap(__float_as_uint(m), __float_as_uint(m), false, false); return fmaxf(__uint_as_float(rr[0]), __uint_as_float(rr[1])); }
__device__ __forceinline__ float swap_sum(float m) { auto rr = __builtin_amdgcn_permlane32_swap(__float_as_uint(m), __float_as_uint(m), false, false); return __uint_as_float(rr[0]) + __uint_as_float(rr[1]); }
#define ATT_WAIT_BAR(N) asm volatile("s_waitcnt vmcnt(" #N ") lgkmcnt(0)\n\ts_barrier" ::: "memory")
#define ATT_LBAR() asm volatile("s_waitcnt lgkmcnt(0)\n\ts_barrier" ::: "memory")

template <bool QK, bool PV, bool NS>
__device__ __forceinline__ void att_step(const LAS char* kp, const int (&koff)[4], const LAS char* vp, const bf16x8 (&qr)[4], f32x16& negm, float& mhat, float& l_reg,
                                         f32x16 (&o)[4], u32x4 (&pw)[4], f32x16& p0, f32x16& p1, LAS float* wsf, int r32, int hi) {
    if (QK) {
        bf16x8 kf[8];
#pragma unroll
        for (int d0 = 0; d0 < 4; ++d0) { kf[2 * d0] = *(const LAS bf16x8*)(kp + koff[d0]); kf[2 * d0 + 1] = *(const LAS bf16x8*)(kp + koff[d0] + 4096); }
        asm volatile("" ::: "memory");
        p0 = __builtin_amdgcn_mfma_f32_32x32x16_bf16(kf[0], qr[0], NS ? f32x16{} : negm, 0, 0, 0); p1 = __builtin_amdgcn_mfma_f32_32x32x16_bf16(kf[1], qr[0], NS ? f32x16{} : negm, 0, 0, 0);
#pragma unroll
        for (int d0 = 1; d0 < 4; ++d0) { p0 = __builtin_amdgcn_mfma_f32_32x32x16_bf16(kf[2 * d0], qr[d0], p0, 0, 0, 0); p1 = __builtin_amdgcn_mfma_f32_32x32x16_bf16(kf[2 * d0 + 1], qr[d0], p1, 0, 0, 0); }
    }
    bf16x8 vc[4];
    if (PV) {
#pragma unroll
        for (int d = 0; d < 4; ++d) { const s16x4 lo = vtr(vp + d * 4096), hh = vtr(vp + d * 4096 + 512); vc[d] = (bf16x8){lo[0], lo[1], lo[2], lo[3], hh[0], hh[1], hh[2], hh[3]}; }
    }
    __builtin_amdgcn_sched_barrier(0);
#pragma unroll
    for (int ks = 0; ks < 4; ++ks) {
        bf16x8 vn[4];
#pragma unroll
        for (int d = 0; d < 4; ++d) {
            if (PV) {
                if (ks < 3) { const s16x4 lo = vtr(vp + d * 4096 + (ks + 1) * 1024), hh = vtr(vp + d * 4096 + (ks + 1) * 1024 + 512); vn[d] = (bf16x8){lo[0], lo[1], lo[2], lo[3], hh[0], hh[1], hh[2], hh[3]}; }
                o[d] = __builtin_amdgcn_mfma_f32_32x32x16_bf16(__builtin_bit_cast(bf16x8, pw[ks]), vc[d], o[d], 0, 0, 0);
            }
            if (QK) { const int e = ks * 4 + d; p0[e] = __builtin_amdgcn_exp2f(p0[e]); p1[e] = __builtin_amdgcn_exp2f(p1[e]); }
            __builtin_amdgcn_sched_barrier(0);
        }
        if (PV && ks < 3) {
#pragma unroll
            for (int d = 0; d < 4; ++d) vc[d] = vn[d];
        }
    }
    if (QK && !NS) {
        float mx[8];
#pragma unroll
        for (int r = 0; r < 8; ++r) mx[r] = fmaxf(fmaxf(p0[r], p0[r + 8]), fmaxf(p1[r], p1[r + 8]));
        float rm = fmaxf(fmaxf(fmaxf(mx[0], mx[1]), fmaxf(mx[2], mx[3])), fmaxf(fmaxf(mx[4], mx[5]), fmaxf(mx[6], mx[7])));
        rm = swap_max(rm);
        if (__any(rm > 256.0f)) {
            const float dl = fmaxf(__builtin_amdgcn_logf(rm), 0.f); mhat += dl;
            const float f = __builtin_amdgcn_exp2f(-dl); l_reg *= f;
#pragma unroll
            for (int r = 0; r < 16; ++r) { p0[r] *= f; p1[r] *= f; negm[r] = -mhat; }
            if (hi == 0) wsf[r32] = f;
#pragma unroll
            for (int r = 0; r < 16; ++r) { const float fr_ = wsf[crow(r, hi)];
#pragma unroll
                for (int d = 0; d < 4; ++d) o[d][r] *= fr_; }
        }
    }
    if (QK) {
        float sacc = 0.f;
#pragma unroll
        for (int r = 0; r < 16; ++r) sacc += p0[r] + p1[r];
        l_reg += sacc;
#pragma unroll
        for (int j = 0; j < 4; ++j) { pw[0][j] = cvt_pk_bf16(p0[2 * j], p0[2 * j + 1]); pw[1][j] = cvt_pk_bf16(p0[8 + 2 * j], p0[8 + 2 * j + 1]);
                                      pw[2][j] = cvt_pk_bf16(p1[2 * j], p1[2 * j + 1]); pw[3][j] = cvt_pk_bf16(p1[8 + 2 * j], p1[8 + 2 * j + 1]); }
    }
}

__device__ __forceinline__ void att_first_ns(const LAS char* kp, const int (&koff)[4], const bf16x8 (&qr)[4], f32x16& n0, f32x16& n1) {
    bf16x8 kf[8];
#pragma unroll
    for (int d0 = 0; d0 < 4; ++d0) { kf[2 * d0] = *(const LAS bf16x8*)(kp + koff[d0]); kf[2 * d0 + 1] = *(const LAS bf16x8*)(kp + koff[d0] + 4096); }
    n0 = __builtin_amdgcn_mfma_f32_32x32x16_bf16(kf[0], qr[0], f32x16{}, 0, 0, 0); n1 = __builtin_amdgcn_mfma_f32_32x32x16_bf16(kf[1], qr[0], f32x16{}, 0, 0, 0);
#pragma unroll
    for (int d0 = 1; d0 < 4; ++d0) { n0 = __builtin_amdgcn_mfma_f32_32x32x16_bf16(kf[2 * d0], qr[d0], n0, 0, 0, 0); n1 = __builtin_amdgcn_mfma_f32_32x32x16_bf16(kf[2 * d0 + 1], qr[d0], n1, 0, 0, 0); }
#pragma unroll
    for (int r = 0; r < 16; ++r) { n0[r] = __builtin_amdgcn_exp2f(n0[r]); n1[r] = __builtin_amdgcn_exp2f(n1[r]); }
}
template <bool QK, bool PV>
__device__ __forceinline__ void att_step_ns(const LAS char* kp, const int (&koff)[4], const LAS char* vp, const bf16x8 (&qr)[4], float& l_reg,
                                            f32x16 (&o)[4], u32x4 (&pw)[4], f32x16& c0, f32x16& c1, f32x16& n0, f32x16& n1) {
#define ATT_KFRAG(g) (*(const LAS bf16x8*)(kp + koff[(g) >> 1] + ((g) & 1) * 4096))
    bf16x8 kr[4];
    if (QK) { kr[0] = ATT_KFRAG(0); kr[1] = ATT_KFRAG(1); kr[2] = ATT_KFRAG(2); kr[3] = ATT_KFRAG(3); }
    __builtin_amdgcn_sched_barrier(0);
    float sacc = 0.f;
#pragma unroll
    for (int g = 0; g < 8; ++g) {
        {   const int w = g >> 1, idx = (w & 1) * 8 + 4 * (g & 1);
            float v0, v1, v2, v3;
            if (w < 2) { v0 = c0[idx]; v1 = c0[idx + 1]; v2 = c0[idx + 2]; v3 = c0[idx + 3]; } else { v0 = c1[idx]; v1 = c1[idx + 1]; v2 = c1[idx + 2]; v3 = c1[idx + 3]; }
            pw[w][2 * (g & 1)] = cvt_pk_bf16(v0, v1); pw[w][2 * (g & 1) + 1] = cvt_pk_bf16(v2, v3);
            sacc += (v0 + v1) + (v2 + v3);
        }
        if (QK) { const int d0 = g >> 1;
            if ((g & 1) == 0) n0 = __builtin_amdgcn_mfma_f32_32x32x16_bf16(kr[g & 3], qr[d0], d0 == 0 ? f32x16{} : n0, 0, 0, 0);
            else              n1 = __builtin_amdgcn_mfma_f32_32x32x16_bf16(kr[g & 3], qr[d0], d0 == 0 ? f32x16{} : n1, 0, 0, 0);
            if (g + 4 < 8) kr[g & 3] = ATT_KFRAG(g + 4); }
        __builtin_amdgcn_sched_barrier(0);
    }
#undef ATT_KFRAG
    l_reg += sacc;
#define ATT_VFRAG(dst, i) do { const s16x4 lo_ = vtr(vp + ((i) & 3) * 4096 + ((i) >> 2) * 1024), hh_ = vtr(vp + ((i) & 3) * 4096 + ((i) >> 2) * 1024 + 512); \
        dst = (bf16x8){lo_[0], lo_[1], lo_[2], lo_[3], hh_[0], hh_[1], hh_[2], hh_[3]}; } while (0)
    bf16x8 vr[4];
    if (PV) { ATT_VFRAG(vr[0], 0); ATT_VFRAG(vr[1], 1); ATT_VFRAG(vr[2], 2); ATT_VFRAG(vr[3], 3); }
    __builtin_amdgcn_sched_barrier(0);
#pragma unroll
    for (int i = 0; i < 16; ++i) {
        if (PV) {
            o[i & 3] = __builtin_amdgcn_mfma_f32_32x32x16_bf16(__builtin_bit_cast(bf16x8, pw[i >> 2]), vr[i & 3], o[i & 3], 0, 0, 0);
            if (i + 4 < 16) ATT_VFRAG(vr[i & 3], i + 4);
        }
        if (QK) { n0[i] = __builtin_amdgcn_exp2f(n0[i]); n1[i] = __builtin_amdgcn_exp2f(n1[i]); }
        __builtin_amdgcn_sched_barrier(0);
    }
#undef ATT_VFRAG
}

template <bool NS> __device__ __forceinline__ void unit(int b, int h, int qb, const bf16_t* Q, const bf16_t* K, const bf16_t* V, bf16_t* CAT, LAS char* lds, float lam, const float* gsub) {
    const int tid = threadIdx.x, lane = tid & 63, r32 = lane & 31, hi = lane >> 5; const int wid = __builtin_amdgcn_readfirstlane(tid >> 6);
    const int c = wid >> 2, rq = wid & 3;
    const long rowbase = (long)b * SEQ; const int q0 = qb * 128;
    const bf16_t* Qw = Q + (rowbase + q0 + rq * 32) * 1024 + h * 128 + c * 64;
    const bf16_t* Kh = K + rowbase * 1024 + h * 128; const bf16_t* Vh = V + rowbase * 1024 + h * 128;
    const unsigned lds0 = (unsigned)(uintptr_t)lds;
    const bf16_t* ksrc = Kh + (long)(8 * wid + (lane >> 3)) * 1024 + (((lane & 7) ^ (lane >> 3)) * 8);
    const bf16_t* vsrc = Vh + (long)(16 * (wid & 3) + (lane >> 2)) * 1024 + (wid >> 2) * 32 + (lane & 3) * 8;
    const unsigned dK0 = lds0 + wid * 1024, dK1 = lds0 + 8192 + wid * 1024, dV0 = lds0 + OFF_V + wid * 1024, dV1 = lds0 + OFF_V + (wid + 8) * 1024;
#define ATT_DMA(t, slot) do { const long to_ = (long)(t) * 64 * 1024; const unsigned so_ = (unsigned)(slot); \
        glds16(ksrc + to_, (unsigned)__builtin_amdgcn_readfirstlane(dK0 + so_)); glds16(ksrc + to_ + 64, (unsigned)__builtin_amdgcn_readfirstlane(dK1 + so_)); \
        glds16(vsrc + to_, (unsigned)__builtin_amdgcn_readfirstlane(dV0 + so_)); glds16(vsrc + to_ + 64, (unsigned)__builtin_amdgcn_readfirstlane(dV1 + so_)); } while (0)
    const int NT = 2 * qb + 2, my_nt = NT - (rq < 2 ? 1 : 0);
    ATT_DMA(0, 0); ATT_DMA(1, SLOT); ATT_DMA((NT > 2) ? 2 : 1, 2 * SLOT);
    bf16x8 qr[4];
#pragma unroll
    for (int d0 = 0; d0 < 4; ++d0) qr[d0] = *reinterpret_cast<const bf16x8*>(&Qw[(long)r32 * 1024 + d0 * 16 + hi * 8]);
    asm volatile("" : "+v"(qr[0]), "+v"(qr[1]), "+v"(qr[2]), "+v"(qr[3]));
    LAS float* wsf = (LAS float*)(lds + OFF_WSF) + wid * 64;
    const LAS char* kp0 = lds + c * 8192 + r32 * 128;
    int koff[4];
#pragma unroll
    for (int d0 = 0; d0 < 4; ++d0) koff[d0] = ((2 * d0 + hi) ^ (r32 & 7)) * 16;
    const LAS char* vp0 = lds + OFF_V + ((lane >> 4) & 1) * 32 + (lane & 3) * 8 + (4 * hi + ((lane & 15) >> 2)) * 64;
    float mhat = 0.f, l_reg = 0.f; f32x16 o[4]; f32x16 negm = f32x16{}, p0 = f32x16{}, p1 = f32x16{}; u32x4 pw[4];
#pragma unroll
    for (int d = 0; d < 4; ++d) o[d] = f32x16{};
#pragma unroll
    for (int j = 0; j < 4; ++j) pw[j] = (u32x4){0u, 0u, 0u, 0u};
    ATT_WAIT_BAR(0);
    if (NS) {
        f32x16 q0, q1;
        att_first_ns(kp0, koff, qr, p0, p1);
        int slot = 0, t = 0;
#define ATT_STEP(C0, C1, N0, N1) do { \
            ATT_WAIT_BAR(4); \
            { const int s3 = (slot >= SLOT) ? slot - SLOT : slot + 3 * SLOT; const int tt = (t + 3 < NT) ? t + 3 : NT - 1; ATT_DMA(tt, s3); } \
            const int nslot = (slot == 3 * SLOT) ? 0 : slot + SLOT; \
            att_step_ns<true, true>(kp0 + nslot, koff, vp0 + slot, qr, l_reg, o, pw, C0, C1, N0, N1); \
            slot = nslot; ++t; } while (0)
        for (int i = 0; i < qb; ++i) { ATT_STEP(p0, p1, q0, q1); ATT_STEP(q0, q1, p0, p1); }
        ATT_STEP(p0, p1, q0, q1);
#undef ATT_STEP
        if (rq >= 2) att_step_ns<false, true>(kp0, koff, vp0 + slot, qr, l_reg, o, pw, q0, q1, p0, p1);
    } else {
    att_step<true, false, NS>(kp0, koff, vp0, qr, negm, mhat, l_reg, o, pw, p0, p1, wsf, r32, hi);
    int slot = 0;
    for (int t = 0; t < NT; ++t) {
        if (t >= 1) { if (t + 2 < NT) { ATT_WAIT_BAR(4); } else { ATT_WAIT_BAR(0); } }
        if (t + 3 < NT) { const int s3 = (slot >= SLOT) ? slot - SLOT : slot + 3 * SLOT; ATT_DMA(t + 3, s3); }
        const int nslot = (slot == 3 * SLOT) ? 0 : slot + SLOT;
        if (t + 1 < my_nt) att_step<true, true, NS>(kp0 + nslot, koff, vp0 + slot, qr, negm, mhat, l_reg, o, pw, p0, p1, wsf, r32, hi);
        else if (t < my_nt) att_step<false, true, NS>(kp0 + nslot, koff, vp0 + slot, qr, negm, mhat, l_reg, o, pw, p0, p1, wsf, r32, hi);
        slot = nslot;
    }
    }
    l_reg = swap_sum(l_reg);
    if (hi == 0) wsf[32 + r32] = l_reg;
#pragma unroll
    for (int r = 0; r < 16; ++r) { const float rl = __builtin_amdgcn_rcpf(wsf[32 + crow(r, hi)]);
#pragma unroll
        for (int d = 0; d < 4; ++d) o[d][r] *= rl; }
    ATT_WAIT_BAR(0);
    LAS float* xf = (LAS float*)(lds + rq * XPAIR);
    if (c == 1) {
#pragma unroll
        for (int d = 0; d < 4; ++d)
#pragma unroll
            for (int r = 0; r < 16; ++r) xf[(d * 16 + r) * 64 + lane] = o[d][r];
    }
    ATT_WAIT_BAR(0);
    if (c == 0) {
#pragma unroll
        for (int d = 0; d < 4; ++d)
#pragma unroll
            for (int r = 0; r < 16; ++r) o[d][r] -= lam * xf[(d * 16 + r) * 64 + lane];
        asm volatile("s_waitcnt lgkmcnt(0)" ::: "memory");
#pragma unroll
        for (int d = 0; d < 4; ++d)
#pragma unroll
            for (int r = 0; r < 16; ++r) xf[crow(r, hi) * 132 + d * 32 + r32] = o[d][r];
        asm volatile("s_waitcnt lgkmcnt(0)" ::: "memory");
        const int row = lane >> 1, half = lane & 1;
        f32x4 v[16]; float ss = 0.f;
#pragma unroll
        for (int i = 0; i < 16; ++i) { v[i] = *(const LAS f32x4*)(xf + row * 132 + half * 64 + i * 4); ss += (v[i][0] * v[i][0] + v[i][1] * v[i][1]) + (v[i][2] * v[i][2] + v[i][3] * v[i][3]); }
        ss += __shfl_xor(ss, 1);
        const float rs = __builtin_amdgcn_rsqf(ss * (1.0f / 128.0f) + RMS_EPS) * (1.0f - LAMBDA_INIT);
        bf16_t* op = CAT + (size_t)(rowbase + q0 + rq * 32 + row) * 2048 + 1024 + h * 128 + half * 64;
#pragma unroll
        for (int i = 0; i < 8; ++i) { const f32x4 g0 = *(const f32x4*)(gsub + half * 64 + i * 8), g1 = *(const f32x4*)(gsub + half * 64 + i * 8 + 4);
            const f32x4 a = v[2 * i] * rs * g0, bq = v[2 * i + 1] * rs * g1;
            u32x4 w; w.x = cvt_pk_bf16(a[0], a[1]); w.y = cvt_pk_bf16(a[2], a[3]); w.z = cvt_pk_bf16(bq[0], bq[1]); w.w = cvt_pk_bf16(bq[2], bq[3]);
            *(u32x4*)(op + i * 8) = w; }
    }
    ATT_WAIT_BAR(0);
#undef ATT_DMA
}
}

namespace ssm {
constexpr int TROW = 132, TILE_BYTES = 32 * TROW * 4;
constexpr int OFF_SEG = 8 * TILE_BYTES;
__device__ __forceinline__ int crow(int r, int hi) { return (r & 3) + 8 * (r >> 2) + 4 * hi; }
__device__ __forceinline__ void item(int b, int g, const bf16_t* UG, bf16_t* YS, const float* AV, const float* A1K, const bf16_t* BB, const bf16_t* CM, const float* dvec, LAS char* lds) {
    const int tid = threadIdx.x, lane = tid & 63, r32 = lane & 31, hi = lane >> 5; const int wid = __builtin_amdgcn_readfirstlane(tid >> 6);
    const int bg = b * NG + g;
    bf16x8 bfr[4], cfr[4];
#pragma unroll
    for (int nt = 0; nt < 4; ++nt) bfr[nt] = *(const bf16x8*)(BB + ((size_t)(g * 128 + nt * 32 + r32) * 16 + 8 * hi));
#pragma unroll
    for (int s = 0; s < 4; ++s) cfr[s] = *(const bf16x8*)(CM + ((size_t)(g * 16 + (lane & 15)) * 128 + 32 * s + 8 * (lane >> 4)));
    const float ar = AV[(g * 64 + lane) * 2], ai = AV[(g * 64 + lane) * 2 + 1];
    const float kr = A1K[(g * 64 + lane) * 2], ki = A1K[(g * 64 + lane) * 2 + 1];
    bf16x8 dfr;
    { const float dq = dvec[g * 16 + (lane & 15)]; const short db = (short)f2bf(dq);
#pragma unroll
      for (int j = 0; j < 8; ++j) dfr[j] = (8 * (lane >> 4) + j == (lane & 15)) ? db : (short)0; }
    LAS float* T = (LAS float*)(lds + wid * TILE_BYTES);
    LAS float* SEG = (LAS float*)(lds + OFF_SEG);
    const bf16_t* Ub = UG + (size_t)bg * SEQ * 16;
    const int tseg = wid * 1024;
    float hr = 0.f, him = 0.f;
    {
        const float aAr = AV[(g * 64 + r32) * 2], aAi = AV[(g * 64 + r32) * 2 + 1], aBr = AV[(g * 64 + 32 + r32) * 2], aBi = AV[(g * 64 + 32 + r32) * 2 + 1];
        float pAr = aAr, pAi = aAi, pBr = aBr, pBi = aBi;
#pragma unroll
        for (int i = 0; i < 4; ++i) { const float nr = pAr * pAr - pAi * pAi, ni = 2.0f * pAr * pAi; pAr = nr; pAi = ni; const float mr = pBr * pBr - pBi * pBi, mi = 2.0f * pBr * pBi; pBr = mr; pBi = mi; }
        const int tokperm = (r32 & 3) + 4 * (r32 >> 3) + 16 * ((r32 >> 2) & 1);
        float cAr = 0.f, cAi = 0.f, cBr = 0.f, cBi = 0.f;
        for (int tile = 0; tile < 32; ++tile) {
            const int t0 = tseg + tile * 32;
            const bf16x8 ufr = *(const bf16x8*)(Ub + (size_t)(t0 + tokperm) * 16 + 8 * hi);
            f32x16 ac[4];
#pragma unroll
            for (int nt = 0; nt < 4; ++nt) ac[nt] = __builtin_amdgcn_mfma_f32_32x32x16_bf16(ufr, bfr[nt], f32x16{}, 0, 0, 0);
            float sAr = 0.f, sAi = 0.f, sBr = 0.f, sBi = 0.f;
#pragma unroll
            for (int r = 0; r < 16; ++r) {
                const float nr = fmaf(aAr, sAr, fmaf(-aAi, sAi, ac[0][r])), ni = fmaf(aAr, sAi, fmaf(aAi, sAr, ac[2][r])); sAr = nr; sAi = ni;
                const float mr = fmaf(aBr, sBr, fmaf(-aBi, sBi, ac[1][r])), mi = fmaf(aBr, sBi, fmaf(aBi, sBr, ac[3][r])); sBr = mr; sBi = mi; }
            const float oAr = __shfl_xor(sAr, 32), oAi = __shfl_xor(sAi, 32), oBr = __shfl_xor(sBr, 32), oBi = __shfl_xor(sBi, 32);
            const float l0Ar = hi ? oAr : sAr, l0Ai = hi ? oAi : sAi, l1Ar = hi ? sAr : oAr, l1Ai = hi ? sAi : oAi;
            const float l0Br = hi ? oBr : sBr, l0Bi = hi ? oBi : sBi, l1Br = hi ? sBr : oBr, l1Bi = hi ? sBi : oBi;
            { const float tr = l0Ar + pAr * cAr - pAi * cAi, ti = l0Ai + pAr * cAi + pAi * cAr; cAr = l1Ar + pAr * tr - pAi * ti; cAi = l1Ai + pAr * ti + pAi * tr; }
            { const float tr = l0Br + pBr * cBr - pBi * cBi, ti = l0Bi + pBr * cBi + pBi * cBr; cBr = l1Br + pBr * tr - pBi * ti; cBi = l1Bi + pBr * ti + pBi * tr; }
        }
        if (hi == 0) { SEG[(wid * 64 + r32) * 2] = cAr; SEG[(wid * 64 + r32) * 2 + 1] = cAi; SEG[(wid * 64 + 32 + r32) * 2] = cBr; SEG[(wid * 64 + 32 + r32) * 2 + 1] = cBi; }
        __syncthreads();
        float cr = 0.f, ci = 0.f;
        for (int s = 0; s < wid; ++s) { const float sr = SEG[(s * 64 + lane) * 2], si = SEG[(s * 64 + lane) * 2 + 1];
            const float nr = kr * cr - ki * ci + sr, ni = kr * ci + ki * cr + si; cr = nr; ci = ni; }
        hr = cr; him = ci;
        cAr = __shfl(hr, r32); cAi = __shfl(him, r32); cBr = __shfl(hr, 32 + r32); cBi = __shfl(him, 32 + r32);
        for (int tile = 0; tile < 32; ++tile) {
            const int t0 = tseg + tile * 32;
            const bf16x8 ufr = *(const bf16x8*)(Ub + (size_t)(t0 + tokperm) * 16 + 8 * hi);
            f32x16 ac[4];
#pragma unroll
            for (int nt = 0; nt < 4; ++nt) ac[nt] = __builtin_amdgcn_mfma_f32_32x32x16_bf16(ufr, bfr[nt], f32x16{}, 0, 0, 0);
            float sAr = 0.f, sAi = 0.f, sBr = 0.f, sBi = 0.f;
#pragma unroll
            for (int r = 0; r < 16; ++r) {
                const float nr = fmaf(aAr, sAr, fmaf(-aAi, sAi, ac[0][r])), ni = fmaf(aAr, sAi, fmaf(aAi, sAr, ac[2][r])); sAr = nr; sAi = ni;
                const float mr = fmaf(aBr, sBr, fmaf(-aBi, sBi, ac[1][r])), mi = fmaf(aBr, sBi, fmaf(aBi, sBr, ac[3][r])); sBr = mr; sBi = mi; }
            const float l0Ar = __shfl(sAr, r32), l0Ai = __shfl(sAi, r32), l0Br = __shfl(sBr, r32), l0Bi = __shfl(sBi, r32);
            float hAr = hi ? l0Ar + pAr * cAr - pAi * cAi : cAr, hAi = hi ? l0Ai + pAr * cAi + pAi * cAr : cAi;
            float hBr = hi ? l0Br + pBr * cBr - pBi * cBi : cBr, hBi = hi ? l0Bi + pBr * cBi + pBi * cBr : cBi;
#pragma unroll
            for (int r = 0; r < 16; ++r) {
                const float nr = fmaf(aAr, hAr, fmaf(-aAi, hAi, ac[0][r])), ni = fmaf(aAr, hAi, fmaf(aAi, hAr, ac[2][r])); hAr = nr; hAi = ni;
                const float mr = fmaf(aBr, hBr, fmaf(-aBi, hBi, ac[1][r])), mi = fmaf(aBr, hBi, fmaf(aBi, hBr, ac[3][r])); hBr = mr; hBi = mi;
                ((LAS unsigned*)T)[(16 * hi + r) * TROW + r32] = cvt_pk_bf16(hAr, hAi);
                ((LAS unsigned*)T)[(16 * hi + r) * TROW + 32 + r32] = cvt_pk_bf16(hBr, hBi); }
            cAr = __shfl(hAr, 32 + r32); cAi = __shfl(hAi, 32 + r32); cBr = __shfl(hBr, 32 + r32); cBi = __shfl(hBi, 32 + r32);
            asm volatile("s_waitcnt lgkmcnt(0)" ::: "memory");
#pragma unroll
            for (int mt = 0; mt < 2; ++mt) {
                f32x4 ya = (f32x4){0.f, 0.f, 0.f, 0.f};
                { bf16x8 uf = *(const bf16x8*)(Ub + (size_t)(t0 + mt * 16 + (lane & 15)) * 16 + 8 * ((lane >> 4) & 1));
                  if (lane >= 32) uf = (bf16x8){0, 0, 0, 0, 0, 0, 0, 0};
                  ya = __builtin_amdgcn_mfma_f32_16x16x32_bf16(uf, dfr, ya, 0, 0, 0); }
#pragma unroll
                for (int s = 0; s < 4; ++s) { const bf16x8 af = *(const LAS bf16x8*)((const LAS char*)T + (mt * 16 + (lane & 15)) * (TROW * 4) + (32 * s + 8 * (lane >> 4)) * 2);
                    ya = __builtin_amdgcn_mfma_f32_16x16x32_bf16(af, cfr[s], ya, 0, 0, 0); }
#pragma unroll
                for (int rg = 0; rg < 4; ++rg) { const int tl = mt * 16 + 4 * (lane >> 4) + rg;
                    *(LAS unsigned short*)((LAS char*)T + tl * (TROW * 4) + 256 + 2 * (lane & 15)) = f2bf(gelu_f(ya[rg])); }
            }
            asm volatile("s_waitcnt lgkmcnt(0)" ::: "memory");
            { const int tl = lane >> 1, half = lane & 1;
              const u32x4 yv = *(const LAS u32x4*)((const LAS char*)T + tl * (TROW * 4) + 256 + half * 16);
              *(u32x4*)(YS + (size_t)(b * SEQ + t0 + tl) * 1024 + g * 16 + half * 8) = yv; }
            asm volatile("s_waitcnt lgkmcnt(0)" ::: "memory");
        }
    }
    __syncthreads();
}
}

__device__ __forceinline__ void transpose_item(const float* W, int K, int N, bf16_t* WT, LAS float* scr, int item, int lane) {
    const int nblk = N / 32, kb = item / nblk, nb = item % nblk, k0 = 64 * kb, n0 = 32 * nb;
#pragma unroll 8
    for (int i = 0; i < 32; ++i) { const int kk = 2 * i + (lane >> 5); scr[kk * 33 + (lane & 31)] = __builtin_nontemporal_load(W + (size_t)(k0 + kk) * N + n0 + (lane & 31)); }
    asm volatile("s_waitcnt lgkmcnt(0)" ::: "memory");
    const int c = lane & 7;
#pragma unroll
    for (int j = 0; j < 4; ++j) { const int n = (lane >> 3) + 8 * j; const LAS float* s = scr + (8 * c) * 33 + n;
        u32x4 o; o.x = cvt_pk_bf16(s[0 * 33], s[1 * 33]); o.y = cvt_pk_bf16(s[2 * 33], s[3 * 33]); o.z = cvt_pk_bf16(s[4 * 33], s[5 * 33]); o.w = cvt_pk_bf16(s[6 * 33], s[7 * 33]);
        *(u32x4*)(WT + (size_t)(n0 + n) * K + k0 + 8 * c) = o; }
    asm volatile("s_waitcnt lgkmcnt(0)" ::: "memory");
}

__device__ __forceinline__ void norm_row(const float* xrow, bf16_t* orow, const float* gvec, const float* scale, const float* shift, float ssq_in, bool have, int lane) {
    const f32x4* xr = (const f32x4*)xrow + lane;
    f32x4 v[8]; float s = 0.f;
#pragma unroll
    for (int j = 0; j < 8; ++j) { v[j] = __builtin_nontemporal_load(xr + 64 * j); s += (v[j][0] * v[j][0] + v[j][1] * v[j][1]) + (v[j][2] * v[j][2] + v[j][3] * v[j][3]); }
    const float ssq = have ? ssq_in : wave_sum(s);
    const float rs = __builtin_amdgcn_rsqf(ssq * (1.0f / DM) + RMS_EPS);
    u32x2* o8 = (u32x2*)orow + lane;
#pragma unroll
    for (int j = 0; j < 8; ++j) { const f32x4 g4 = ((const f32x4*)gvec)[lane + 64 * j], sc = ((const f32x4*)scale)[lane + 64 * j], sh = ((const f32x4*)shift)[lane + 64 * j];
        const f32x4 h = v[j] * rs * g4 * (sc + 1.0f) + sh;
        u32x2 w; w.x = cvt_pk_bf16(h[0], h[1]); w.y = cvt_pk_bf16(h[2], h[3]); o8[64 * j] = w; }
}

#define XB_TMO      128
#define XB_XCNT(j)  (256  + 64 * (j))
#define XB_XSUB(j)  (1280 + 64 * (j))
#define XB_XGEN(j)  (2304 + 64 * (j))
#define XB_TOP      3328
#define XB_TOPGEN   3392
#define XB_SPIN_CAP (1u << 22)
__device__ __forceinline__ unsigned xb_ld(unsigned* p)              { return __hip_atomic_load(p, __ATOMIC_RELAXED, __HIP_MEMORY_SCOPE_AGENT); }
__device__ __forceinline__ unsigned xb_add(unsigned* p, unsigned v) { return __hip_atomic_fetch_add(p, v, __ATOMIC_RELAXED, __HIP_MEMORY_SCOPE_AGENT); }
__device__ __forceinline__ unsigned xb_xcc_id() { return (unsigned)__builtin_amdgcn_s_getreg((3 << 11) | 20) & 0xFu; }
#define XB_SPIN(cond, bar) do { unsigned _sp = 0; while (cond) { __builtin_amdgcn_s_sleep(1); \
    if ((++_sp & 255u) == 0u) { if (xb_ld(&(bar)[XB_TMO])) break; if (_sp > XB_SPIN_CAP) { atomicAdd(&(bar)[XB_TMO], 1u); break; } } } } while (0)
struct XcdBarrier { unsigned* bar; unsigned x; volatile LAS unsigned* st; };
__device__ __forceinline__ XcdBarrier xcd_barrier_post(unsigned* bar, volatile LAS unsigned* st) {
    XcdBarrier b; b.bar = bar; b.x = xb_xcc_id(); b.st = st;
    if (threadIdx.x == 0) (void)xb_add(&bar[XB_XCNT(b.x)], 1u);
    return b;
}
__device__ __forceinline__ void xcd_barrier_complete(unsigned* bar, unsigned x, unsigned& nloc, unsigned& nx) {
    const unsigned G = gridDim.x * gridDim.y * gridDim.z;
    unsigned sum, cnt, mine, sp = 0u;
    for (;;) {
        sum = 0u; cnt = 0u; mine = 0u;
#pragma unroll
        for (unsigned j = 0; j < 16; ++j) { const unsigned c = xb_ld(&bar[XB_XCNT(j)]); sum += c; cnt += (c > 0u) ? 1u : 0u; mine = (j == x) ? c : mine; }
        if (sum == G) break;
        __builtin_amdgcn_s_sleep(1);
        if ((++sp & 255u) == 0u) { if (xb_ld(&bar[XB_TMO])) break; if (sp > XB_SPIN_CAP) { atomicAdd(&bar[XB_TMO], 1u); break; } }
    }
    nloc = mine > 0u ? mine : 1u; nx = cnt > 0u ? cnt : 1u;
}
__device__ __forceinline__ void xcd_barrier(const XcdBarrier& b) {
    asm volatile("s_waitcnt vmcnt(0)" ::: "memory");
    __syncthreads();
    if (threadIdx.x == 0) {
        unsigned* bar = b.bar;
        __builtin_amdgcn_s_waitcnt(0);
        unsigned nloc = b.st[0], nx = b.st[1];
        if (nloc == 0u) { xcd_barrier_complete(bar, b.x, nloc, nx); b.st[0] = nloc; b.st[1] = nx; }
        const unsigned old = xb_add(&bar[XB_XSUB(b.x)], 1u);
        const unsigned gen = old / nloc;
        if (old + 1u == (gen + 1u) * nloc) {
            __builtin_amdgcn_fence(__ATOMIC_RELEASE, "agent");
            asm volatile("s_waitcnt vmcnt(0)" ::: "memory");
            const unsigned og = xb_add(&bar[XB_TOP], 1u);
            const unsigned tg = og / nx;
            if (og + 1u == (tg + 1u) * nx) xb_add(&bar[XB_TOPGEN], 1u);
            else XB_SPIN(xb_ld(&bar[XB_TOPGEN]) == tg, bar);
            __builtin_amdgcn_fence(__ATOMIC_ACQUIRE, "agent");
            xb_add(&bar[XB_XGEN(b.x)], 1u);
            asm volatile("s_waitcnt vmcnt(0)" ::: "memory");
        } else {
            XB_SPIN(xb_ld(&bar[XB_XGEN(b.x)]) == gen, bar);
            __builtin_amdgcn_fence(__ATOMIC_ACQUIRE, "agent");
            asm volatile("s_waitcnt vmcnt(0)" ::: "memory");
        }
    }
    __syncthreads();
}

struct Args { const float* in[27]; float* out; unsigned char* ws; int ph_lo, ph_hi; };

__global__ void __launch_bounds__(512, 2) fwd_megakernel(Args a) {
    extern __shared__ __attribute__((aligned(16))) unsigned char lds_raw[];
    LAS unsigned char* lds = (LAS unsigned char*)lds_raw;
    cg::grid_group grid = cg::this_grid();
    const int tid = threadIdx.x, lane = tid & 63, wid = __builtin_amdgcn_readfirstlane(tid >> 6);
    const int G = gridDim.x, bx = blockIdx.x;
    const int vcu = (G % 8 == 0) ? (bx % 8) * (G / 8) + bx / 8 : bx;
    const int gw = vcu * 8 + wid, NGW = G * 8;
    unsigned char* ws = a.ws;
    const float* x = a.in[0];
    float* mod = (float*)(ws + WS_MOD); float* rss = (float*)(ws + WS_RSS); float* bias2 = (float*)(ws + WS_B2);
    bf16_t* Hb = (bf16_t*)(ws + WS_H);
    bf16_t *WinT = (bf16_t*)(ws + WS_WIN), *WgluT = (bf16_t*)(ws + WS_WGLU), *WoutT = (bf16_t*)(ws + WS_WOUT), *W1T = (bf16_t*)(ws + WS_W1), *W2T = (bf16_t*)(ws + WS_W2);
    bf16_t *UG = (bf16_t*)(ws + WS_UG), *Qb = (bf16_t*)(ws + WS_Q), *Kb = (bf16_t*)(ws + WS_K), *Vb = (bf16_t*)(ws + WS_V), *YS = (bf16_t*)(ws + WS_YS), *CAT = (bf16_t*)(ws + WS_CAT), *ACT = (bf16_t*)(ws + WS_ACT);
    float *AV = (float*)(ws + WS_AV), *A1K = (float*)(ws + WS_A1K); bf16_t *BB = (bf16_t*)(ws + WS_BB), *CM = (bf16_t*)(ws + WS_CM);
    const int lo = a.ph_lo, hi_ph = a.ph_hi;
#define IN(k) (lo <= (k) && (k) < hi_ph)
    volatile LAS unsigned* bst = (volatile LAS unsigned*)(lds + LDS_BYTES - 64);
    if (tid < 2) bst[tid] = 0u;
    __syncthreads();
    XcdBarrier xbar; xbar.bar = (unsigned*)(ws + WS_CTL); xbar.x = 0; xbar.st = bst;
    if (bx == 0) for (int i = tid; i < (int)(CTL_BYTES / 4); i += 512) ((unsigned*)(ws + WS_CTL))[i] = 0u;
#define SEAM(k) do { if (IN(k) && IN((k) + 1)) { if ((k) == 0) grid.sync(); else xcd_barrier(xbar); } } while (0)

    if (IN(0)) {
        LAS float* sl = (LAS float*)lds;
        LAS float* red = (LAS float*)(lds + 32768);
        if (bx < 192) {
            const float* cc = a.in[1];
            for (int i = tid; i < NB * DM; i += 512) { const float v = cc[i]; sl[i] = v / (1.0f + __expf(-v)); }
            __syncthreads();
            for (int it = bx; it < 192; it += G) {
                const float* wp = a.in[2] + (size_t)(wid * 256) * 12288 + it * 64 + lane;
                float ac[4] = {0.f, 0.f, 0.f, 0.f};
#pragma unroll 8
                for (int k = 0; k < 256; ++k) { const float w = __builtin_nontemporal_load(wp + (size_t)k * 12288); const int kk = wid * 256 + k;
                    ac[0] = fmaf(sl[kk], w, ac[0]); ac[1] = fmaf(sl[2048 + kk], w, ac[1]); ac[2] = fmaf(sl[4096 + kk], w, ac[2]); ac[3] = fmaf(sl[6144 + kk], w, ac[3]); }
#pragma unroll
                for (int b = 0; b < 4; ++b) red[(wid * 4 + b) * 64 + lane] = ac[b];
                __syncthreads();
                if (wid < 4) { float s = a.in[3][it * 64 + lane];
#pragma unroll
                    for (int w = 0; w < 8; ++w) s += red[(w * 4 + wid) * 64 + lane];
                    mod[(size_t)wid * 12288 + it * 64 + lane] = s; }
                __syncthreads();
            }
        }
        {
            LAS float* scr = (LAS float*)(lds + 40960 + wid * 8448);
            constexpr int I_IN = (DM / 64) * (INW / 32), I_GLU = (SSMW / 64) * (SSMW / 32), I_OUT = (DM / 64) * (DM / 32), I_1 = (DM / 64) * (HID / 32), I_2 = (HID / 64) * (DM / 32);
            constexpr int NITEMS = I_IN + I_GLU + I_OUT + I_1 + I_2;
            const int gw2 = ((vcu + 64) % G) * 8 + wid;
            for (int it = gw2; it < NITEMS; it += NGW) {
                int r = it;
                if (r < I_IN) { transpose_item(a.in[6], DM, INW, WinT, scr, r, lane); continue; } r -= I_IN;
                if (r < I_GLU) { transpose_item(a.in[15], SSMW, SSMW, WgluT, scr, r, lane); continue; } r -= I_GLU;
                if (r < I_OUT) { transpose_item(a.in[24], DM, DM, WoutT, scr, r, lane); continue; } r -= I_OUT;
                if (r < I_1) { transpose_item(a.in[25], DM, HID, W1T, scr, r, lane); continue; } r -= I_1;
                transpose_item(a.in[26], HID, DM, W2T, scr, r, lane);
            }
        }
        {
            const int gt = bx * 512 + tid;
            if (gt < NG * NP) {
                const int g = gt >> 6, p = gt & 63;
                const float dt = expf(a.in[14][g]), lr = a.in[7][gt], li = a.in[8][gt];
                const float mag = expf(dt * lr); float sn, cs; sincosf(dt * li, &sn, &cs);
                const float ar = mag * cs, ai = mag * sn, den = lr * lr + li * li, zr = ar - 1.0f;
                const float kr = (zr * lr + ai * li) / den, ki = (ai * lr - zr * li) / den;
                AV[gt * 2] = ar; AV[gt * 2 + 1] = ai;
                float pr = ar, pi = ai;
                for (int i = 0; i < 10; ++i) { const float nr = pr * pr - pi * pi, ni = 2.0f * pr * pi; pr = nr; pi = ni; }
                A1K[gt * 2] = pr; A1K[gt * 2 + 1] = pi;
                for (int h = 0; h < 16; ++h) { const float br = a.in[9][gt * 16 + h], bi = a.in[10][gt * 16 + h];
                    BB[(size_t)(g * 128 + p) * 16 + h] = f2bf(kr * br - ki * bi); BB[(size_t)(g * 128 + 64 + p) * 16 + h] = f2bf(kr * bi + ki * br); }
                for (int q = 0; q < 16; ++q) { CM[(size_t)(g * 16 + q) * 128 + 2 * p] = f2bf(a.in[11][(g * 16 + q) * 64 + p]); CM[(size_t)(g * 16 + q) * 128 + 2 * p + 1] = f2bf(-a.in[12][(g * 16 + q) * 64 + p]); }
            }
            for (int i = gt; i < MTOK; i += G * 512) rss[i] = 0.f;
        }
    }
    SEAM(0);
    if (lo == 0 && hi_ph > 1) xbar = xcd_barrier_post((unsigned*)(ws + WS_CTL), bst);
    if (IN(1)) {
        for (int m = gw; m < MTOK; m += NGW) { const int b = m >> 13;
            norm_row(x + (size_t)m * DM, Hb + (size_t)m * DM, a.in[4], mod + (size_t)b * 12288 + 2048, mod + (size_t)b * 12288, 0.f, false, lane); }
        for (int n = gw; n < HID; n += NGW) {
            const u32x4* wp = (const u32x4*)(W1T + (size_t)n * DM + lane * 32);
            float wv[32];
#pragma unroll
            for (int i = 0; i < 4; ++i) { const u32x4 w = wp[i]; wv[8 * i] = bflo(w.x); wv[8 * i + 1] = bfhi(w.x); wv[8 * i + 2] = bflo(w.y); wv[8 * i + 3] = bfhi(w.y);
                wv[8 * i + 4] = bflo(w.z); wv[8 * i + 5] = bfhi(w.z); wv[8 * i + 6] = bflo(w.w); wv[8 * i + 7] = bfhi(w.w); }
#pragma unroll
            for (int b = 0; b < NB; ++b) { const f32x4* sp = (const f32x4*)(mod + (size_t)b * 12288 + 3 * 2048 + lane * 32); float sacc = 0.f;
#pragma unroll
                for (int i = 0; i < 8; ++i) { const f32x4 sv = sp[i]; sacc += (sv[0] * wv[4 * i] + sv[1] * wv[4 * i + 1]) + (sv[2] * wv[4 * i + 2] + sv[3] * wv[4 * i + 3]); }
                sacc = wave_sum(sacc); if (lane == 0) bias2[(size_t)b * HID + n] = sacc; }
        }
    }
    SEAM(1);
    if (IN(2)) {
        pg8::Gemm g{Hb, WinT, MTOK, INW, DM}; pg8::StaticOrder S; S.init(MTOK, INW, G, bx, 4);
        EpiInProj E{UG, Qb, Kb, Vb, a.in[17], a.in[18]};
        pg8::gemm_phase<EpiInProj>(lds, g, S, E);
    }
    SEAM(2);
    if (IN(3)) {
        for (int it = vcu; it < NB * NG; it += G) ssm::item(it >> 6, it & 63, UG, YS, AV, A1K, BB, CM, a.in[13], (LAS char*)lds);
    }
    SEAM(3);
    if (IN(4)) {
        { pg8::Gemm g{YS, WgluT, MTOK, SSMW, SSMW}; pg8::StaticOrder S; S.init(MTOK, SSMW, G, bx, 4);
          EpiGlu E{YS, CAT, a.in[16]};
          pg8::gemm_phase<EpiGlu>(lds, g, S, E); }
        float lam;
        { const float p1 = lane < 64 ? a.in[19][lane] * a.in[20][lane] : 0.f, p2 = a.in[21][lane] * a.in[22][lane];
          lam = __expf(wave_sum(p1)) - __expf(wave_sum(p2)) + LAMBDA_INIT; }
        bool fastp;
        { float mq = fabsf(a.in[17][lane]), mk = fabsf(a.in[18][lane]);
#pragma unroll
          for (int o_ = 1; o_ < 64; o_ <<= 1) { mq = fmaxf(mq, __shfl_xor(mq, o_)); mk = fmaxf(mk, __shfl_xor(mk, o_)); }
          fastp = (64.0f * QSCALE * mq * mk * 1.05f) < 60.0f; }
        { const int nu = (G == 256) ? 8 : (2048 - vcu + G - 1) / G;
          for (int i = 0; i < nu; ++i) { int bh, qb;
              if (G == 256) { const int j = vcu & 31; bh = (vcu >> 5) * 4 + (i >> 1); qb = (i & 1) ? j : 63 - j; }
              else { const int u = vcu + i * G; bh = u >> 6; qb = 63 - (u & 63); }
              if (fastp) att::unit<true>(bh >> 3, bh & 7, qb, Qb, Kb, Vb, CAT, (LAS char*)lds, lam, a.in[23]);
              else att::unit<false>(bh >> 3, bh & 7, qb, Qb, Kb, Vb, CAT, (LAS char*)lds, lam, a.in[23]); } }
    }
    SEAM(4);
    if (IN(5)) {
        pg8::Gemm g{CAT, WoutT, MTOK, DM, DM}; pg8::StaticOrder S; S.init(MTOK, DM, G, bx, 8);
        EpiResid<true> E{x, a.out, mod + 4096, rss, a.in[5], mod + 4 * 2048, Hb};
        pg8::gemm_phase<EpiResid<true>>(lds, g, S, E);
    }
    SEAM(5);
    if (IN(7)) {
        pg8::Gemm g{Hb, W1T, MTOK, HID, DM}; pg8::StaticOrder S; S.init(MTOK, HID, G, bx, 4);
        EpiMlp1 E{ACT, rss, bias2};
        pg8::gemm_phase<EpiMlp1>(lds, g, S, E);
    }
    SEAM(7);
    if (IN(8)) {
        pg8::Gemm g{ACT, W2T, MTOK, DM, HID}; pg8::StaticOrder S; S.init(MTOK, DM, G, bx, 8);
        EpiResid<false> E{a.out, a.out, mod + 5 * 2048, nullptr, nullptr, nullptr, nullptr};
        pg8::gemm_phase<EpiResid<false>>(lds, g, S, E);
    }
#undef IN
#undef SEAM
}

#ifndef MK_PER_PHASE
#define MK_PER_PHASE 0
#endif
extern "C" void kernel_launch(void* const* d_in, const int* in_sizes, int n_in, void* d_out, int out_size, void* d_ws, size_t ws_size, hipStream_t stream) {
    static int grid = 0;
    if (grid == 0) {
        if (n_in != 27 || out_size != MTOK * DM || ws_size < WS_END) { fprintf(stderr, "kernel_launch: unexpected shapes (n_in %d out %d ws %zu)\n", n_in, out_size, ws_size); grid = -1; return; }
        int dev = 0, cus = 0, per_cu = 0;
        hipGetDevice(&dev); hipDeviceGetAttribute(&cus, hipDeviceAttributeMultiprocessorCount, dev);
        if (hipFuncSetAttribute((const void*)fwd_megakernel, hipFuncAttributeMaxDynamicSharedMemorySize, LDS_BYTES) != hipSuccess) { fprintf(stderr, "kernel_launch: hipFuncSetAttribute failed\n"); grid = -1; return; }
        hipOccupancyMaxActiveBlocksPerMultiprocessor(&per_cu, (const void*)fwd_megakernel, 512, LDS_BYTES);
        (void)hipGetLastError();
        if (per_cu < 1) per_cu = 1;
        grid = cus;
        fprintf(stderr, "kernel_launch: cus %d per_cu %d grid %d\n", cus, per_cu, grid);
    }
    if (grid < 0) return;
    Args a{};
    for (int i = 0; i < 27; ++i) a.in[i] = (const float*)d_in[i];
    a.out = (float*)d_out; a.ws = (unsigned char*)d_ws;
#if MK_PER_PHASE
    for (int p = 0; p < 9; ++p) { a.ph_lo = p; a.ph_hi = p + 1; void* args[] = {&a};
        hipError_t e = hipLaunchCooperativeKernel((const void*)fwd_megakernel, dim3(grid), dim3(512), args, LDS_BYTES, stream);
        if (e != hipSuccess) fprintf(stderr, "launch %d failed: %s\n", p, hipGetErrorString(e)); }
#else
    a.ph_lo = 0; a.ph_hi = 9; void* args[] = {&a};
    hipError_t e = hipLaunchCooperativeKernel((const void*)fwd_megakernel, dim3(grid), dim3(512), args, LDS_BYTES, stream);
    if (e != hipSuccess) fprintf(stderr, "cooperative launch failed: %s (grid %d)\n", hipGetErrorString(e), grid);
#endif
}
```

```cpp
#include <hip/hip_runtime.h>
#include <hip/hip_cooperative_groups.h>
#include <cstdio>
#include <cstdint>
#include <cmath>
namespace cg = cooperative_groups;

#define LAS __attribute__((address_space(3)))
typedef unsigned short bf16_t;
typedef short bf16x8 __attribute__((ext_vector_type(8)));
typedef short s16x4 __attribute__((ext_vector_type(4)));
typedef float f32x4 __attribute__((ext_vector_type(4)));
typedef float f32x16 __attribute__((ext_vector_type(16)));
typedef unsigned u32x4 __attribute__((ext_vector_type(4)));
typedef unsigned u32x2 __attribute__((ext_vector_type(2)));

constexpr int NB = 4, SEQ = 8192, DM = 2048, MTOK = NB * SEQ;
constexpr int SSMW = 1024, ATW = 1024, INW = 4096, HID = 8192;
constexpr int NG = 64, NP = 64;
constexpr float RMS_EPS = 1e-6f;
constexpr float LAMBDA_INIT = 0.2f;
constexpr float QSCALE = 0.125f * 1.4426950408889634f;

constexpr size_t MiB = 1u << 20;
constexpr size_t WS_ACT = 0;
constexpr size_t WS_UG = 0;
constexpr size_t WS_Q = 64 * MiB;
constexpr size_t WS_K = 128 * MiB;
constexpr size_t WS_V = 192 * MiB;
constexpr size_t WS_YS = 256 * MiB;
constexpr size_t WS_CAT = 320 * MiB;
constexpr size_t WS_H = 512 * MiB;
constexpr size_t WS_WIN = 640 * MiB;
constexpr size_t WS_WGLU = 656 * MiB;
constexpr size_t WS_WOUT = 658 * MiB;
constexpr size_t WS_W1 = 666 * MiB;
constexpr size_t WS_W2 = 698 * MiB;
constexpr size_t WS_MOD = 730 * MiB;
constexpr size_t WS_RSS = 730 * MiB + 256 * 1024;
constexpr size_t WS_AV = 731 * MiB;
constexpr size_t WS_A1K = 731 * MiB + 32 * 1024;
constexpr size_t WS_BB = 731 * MiB + 64 * 1024;
constexpr size_t WS_CM = 731 * MiB + 320 * 1024;
constexpr size_t WS_B2 = 731 * MiB + 640 * 1024;
constexpr size_t WS_CTL = 731 * MiB + 832 * 1024;
constexpr size_t CTL_BYTES = 16384;
constexpr size_t WS_X1B = 736 * MiB;
constexpr size_t WS_END = 864 * MiB;

constexpr int LDS_BYTES = 147456;

__device__ __forceinline__ unsigned cvt_pk_bf16(float lo, float hi) { unsigned r; asm volatile("v_cvt_pk_bf16_f32 %0, %1, %2" : "=v"(r) : "v"(lo), "v"(hi)); return r; }
__device__ __forceinline__ float bf2f(unsigned short v) { return __uint_as_float((unsigned)v << 16); }
__device__ __forceinline__ float bflo(unsigned v) { return __uint_as_float(v << 16); }
__device__ __forceinline__ float bfhi(unsigned v) { return __uint_as_float(v & 0xffff0000u); }
__device__ __forceinline__ unsigned short f2bf(float f) { return (unsigned short)(cvt_pk_bf16(f, 0.f) & 0xffffu); }
__device__ __forceinline__ float gelu_f(float v) {
    const float av = fabsf(v), t = __builtin_amdgcn_rcpf(av * 0.2316418882f + 1.0f);
    float q = t * 0.5307027145f + (-0.7265760135f); q = q * t + 0.7107068705f; q = q * t + (-0.142248368f); q = q * t + 0.127414796f; q = q * t;
    const float e = __builtin_amdgcn_exp2f((v * v) * (-0.72134752044f));
    const float m = v * (q * e);
    return v < 0.f ? m : v - m;
}
__device__ __forceinline__ float wave_sum(float v) {
#pragma unroll
    for (int o = 1; o < 64; o <<= 1) v += __shfl_xor(v, o);
    return v;
}

namespace pg8 {
constexpr int BM = 256, BK = 64, HALF = 128, HTB = HALF * BK * 2, STAGE_BYTES = 8 * HTB, NXCD = 8;
__host__ __device__ __forceinline__ int lds_byte(int r, int c) { const int st = (r >> 4) * 2 + (c >> 5), rr = r & 15, cc = c & 31, ob = rr * 64 + cc * 2; return st * 1024 + (ob ^ (((ob >> 9) & 1) << 5)); }
__host__ __device__ __forceinline__ void stage_rc(int b, int& R, int& C) { const int st = b / 1024, sb = b % 1024, swz = sb ^ (((sb >> 9) & 1) << 5); R = (st >> 1) * 16 + swz / 64; C = (st & 1) * 32 + (swz % 64) / 2; }
__host__ __device__ __forceinline__ int perm32(int rho) { const int n = rho >> 4, i = rho & 15; return 8 * (i >> 2) + 4 * n + (i & 3); }

struct Unit { int pm, pn; };
struct Gemm { const bf16_t* A; const bf16_t* Bt; int M, N, K; };

struct StaticOrder {
    int nM, nN, nwg, G, c, WGM;
    __device__ void init(int M, int N, int G_, int c_, int wgm) { nM = M / BM; nN = N / BM; nwg = nM * nN; G = G_; c = c_; WGM = wgm; }
    __device__ bool next(int i, Unit& u) const {
        const long L = (long)i * G + c; if (L >= nwg) return false;
        int wgid = (int)L; { const int q = nwg / NXCD, r = nwg % NXCD, xcd = wgid % NXCD, off = wgid / NXCD; wgid = (xcd < r ? xcd * (q + 1) : r * (q + 1) + (xcd - r) * q) + off; }
        const int nig = WGM * nN, gid = wgid / nig, fm = gid * WGM, gsz = (nM - fm) < WGM ? (nM - fm) : WGM;
        u.pm = fm + ((wgid % nig) % gsz); u.pn = (wgid % nig) / gsz; return true;
    }
};

template <class Epi>
__device__ __forceinline__ void gemm_phase(LAS unsigned char* lds, const Gemm g, const StaticOrder& S, const Epi& E) {
    const int tid = threadIdx.x, wid = __builtin_amdgcn_readfirstlane(tid >> 6), lane = tid & 63, wr = wid >> 2, wc = wid & 3, fr = lane & 15, fq = lane >> 4;
    const int K = g.K, nt = K / BK;
    unsigned voffA[2], voffB[2];
#pragma unroll
    for (int i = 0; i < 2; ++i) { int R, C; stage_rc(tid * 16 + i * 8192, R, C);
        const int Rb = (Epi::BMODE == 2) ? (64 * (R >> 5) + perm32(R & 31)) : R;
        voffA[i] = (unsigned)(R * K + C) * 2u; voffB[i] = (unsigned)(Rb * K + C) * 2u; }
    const size_t kstep = (size_t)(BK * 2);
    const size_t hstep = (size_t)HALF * K * 2;
    const size_t hstepB = (Epi::BMODE == 2) ? (size_t)32 * K * 2 : hstep;
    const size_t tstep = 2 * hstep;
    const unsigned ldsw = (unsigned)wid * 1024u;
    const int aoff = lds_byte(wr * 64 + fr, fq * 8), boff = lds_byte(wc * 32 + fr, fq * 8);
#define PG8_SA(b, h) (((b) * 2 + (h)) * HTB)
#define PG8_SB(b, h) ((4 + (b) * 2 + (h)) * HTB)
#define PG8_STAGE(bufoff, gbase, voff) do { _Pragma("unroll") for (int _i = 0; _i < 2; ++_i) \
        __builtin_amdgcn_global_load_lds((const unsigned*)((const char*)(gbase) + (voff)[_i]), (LAS unsigned*)(lds + (bufoff) + ldsw + _i * 8192), 16, 0, 0); } while (0)
#define PG8_LDA(dst, b, h) do { _Pragma("unroll") for (int m = 0; m < 4; ++m) _Pragma("unroll") for (int k = 0; k < 2; ++k) dst[m][k] = *(const LAS bf16x8*)(lds + PG8_SA(b, h) + aoff + m * 2048 + k * 1024); } while (0)
#define PG8_LDB(dst, b, h) do { _Pragma("unroll") for (int n = 0; n < 2; ++n) _Pragma("unroll") for (int k = 0; k < 2; ++k) dst[n][k] = *(const LAS bf16x8*)(lds + PG8_SB(b, h) + boff + n * 2048 + k * 1024); } while (0)
#define PG8_MMA(ai, bj, At, Bt) do { __builtin_amdgcn_s_setprio(1); _Pragma("unroll") for (int m = 0; m < 4; ++m) _Pragma("unroll") for (int n = 0; n < 2; ++n) _Pragma("unroll") for (int k = 0; k < 2; ++k) \
        acc[ai][bj][m][n] = __builtin_amdgcn_mfma_f32_16x16x32_bf16(Bt[n][k], At[m][k], acc[ai][bj][m][n], 0, 0, 0); __builtin_amdgcn_s_setprio(0); } while (0)
#define PG8_WAIT_V(n) asm volatile("s_waitcnt vmcnt(" #n ")" ::: "memory")
#define PG8_WAIT_L(n) asm volatile("s_waitcnt lgkmcnt(" #n ")" ::: "memory")
#define PG8_BAR __builtin_amdgcn_s_barrier()
#define PG8_SCHED __builtin_amdgcn_sched_barrier(0)
    Unit cur, nxt; int ui = 0;
    if (!S.next(0, cur)) return;
    f32x4 acc[2][2][4][2];
#pragma unroll
    for (int a = 0; a < 2; ++a)
#pragma unroll
        for (int b = 0; b < 2; ++b)
#pragma unroll
            for (int m = 0; m < 4; ++m)
#pragma unroll
                for (int n = 0; n < 2; ++n) acc[a][b][m][n] = (f32x4){0.f, 0.f, 0.f, 0.f};
    bf16x8 At[4][2], B0[2][2], B1[2][2];
    const char* cA = (const char*)g.A + (size_t)cur.pm * tstep; const char* cB = (const char*)g.Bt + (size_t)cur.pn * tstep;
    PG8_STAGE(PG8_SB(0, 0), cB, voffB); PG8_STAGE(PG8_SB(0, 1), cB + hstepB, voffB); PG8_STAGE(PG8_SA(0, 0), cA, voffA); PG8_STAGE(PG8_SA(0, 1), cA + hstep, voffA);
    if (wr == 1) PG8_BAR;
    PG8_WAIT_V(2); PG8_BAR;
    PG8_STAGE(PG8_SB(1, 0), cB + kstep, voffB); PG8_STAGE(PG8_SA(1, 0), cA + kstep, voffA); PG8_STAGE(PG8_SB(1, 1), cB + hstepB + kstep, voffB);
    PG8_WAIT_V(6); PG8_BAR;
    for (;;) {
        const bool has_next = S.next(ui + 1, nxt);
        const char* nA = has_next ? (const char*)g.A + (size_t)nxt.pm * tstep : cA; const char* nB = has_next ? (const char*)g.Bt + (size_t)nxt.pn * tstep : cB;
        for (int t = 0; t < nt; t += 2) {
            const bool last = (t == nt - 2);
            const char* a1 = cA + (size_t)(t + 1) * kstep;
            const char* a2 = last ? nA : cA + (size_t)(t + 2) * kstep; const char* b2 = last ? nB : cB + (size_t)(t + 2) * kstep;
            const char* a3 = a2 + kstep; const char* b3 = b2 + kstep;
            PG8_LDB(B0, 0, 0); PG8_LDB(B1, 0, 1); PG8_SCHED; PG8_LDA(At, 0, 0); PG8_STAGE(PG8_SA(1, 1), a1 + hstep, voffA);
            PG8_WAIT_V(8); PG8_WAIT_L(0); PG8_BAR; PG8_MMA(0, 0, At, B0); PG8_MMA(0, 1, At, B1); PG8_BAR; PG8_SCHED;
            PG8_LDA(At, 0, 1); PG8_STAGE(PG8_SB(0, 0), b2, voffB); PG8_STAGE(PG8_SB(0, 1), b2 + hstepB, voffB); PG8_STAGE(PG8_SA(0, 0), a2, voffA);
            PG8_WAIT_V(8); PG8_WAIT_L(0); PG8_BAR; PG8_MMA(1, 0, At, B0); PG8_MMA(1, 1, At, B1); PG8_BAR; PG8_SCHED;
            PG8_LDB(B0, 1, 0); PG8_LDB(B1, 1, 1); PG8_SCHED; PG8_LDA(At, 1, 0); PG8_STAGE(PG8_SA(0, 1), a2 + hstep, voffA);
            PG8_WAIT_V(8); PG8_WAIT_L(0); PG8_BAR; PG8_MMA(0, 0, At, B0); PG8_MMA(0, 1, At, B1); PG8_BAR; PG8_SCHED;
            PG8_LDA(At, 1, 1); PG8_STAGE(PG8_SB(1, 0), b3, voffB); PG8_STAGE(PG8_SB(1, 1), b3 + hstepB, voffB); PG8_STAGE(PG8_SA(1, 0), a3, voffA);
            PG8_WAIT_V(8); PG8_WAIT_L(0); PG8_BAR; PG8_MMA(1, 0, At, B0); PG8_MMA(1, 1, At, B1); PG8_BAR; PG8_SCHED;
        }
        if (wr == 0) PG8_BAR;
        E(acc, cur, wr, wc, fr, fq);
        if (!has_next) break;
#pragma unroll
        for (int a = 0; a < 2; ++a)
#pragma unroll
            for (int b = 0; b < 2; ++b)
#pragma unroll
                for (int m = 0; m < 4; ++m)
#pragma unroll
                    for (int n = 0; n < 2; ++n) acc[a][b][m][n] = (f32x4){0.f, 0.f, 0.f, 0.f};
        cur = nxt; cA = nA; cB = nB; ++ui;
        if (wr == 1) PG8_BAR;
    }
    PG8_WAIT_V(0);
    PG8_BAR;
#undef PG8_SA
#undef PG8_SB
#undef PG8_STAGE
#undef PG8_LDA
#undef PG8_LDB
#undef PG8_MMA
#undef PG8_WAIT_V
#undef PG8_WAIT_L
#undef PG8_BAR
#undef PG8_SCHED
}
}

struct EpiInProj {
    static constexpr int BMODE = 2;
    bf16_t *UG, *Q, *Kb, *V; const float *gq, *gk;
    __device__ __forceinline__ void operator()(const f32x4 (&acc)[2][2][4][2], const pg8::Unit& u, int wr, int wc, int fr, int fq) const {
        const int sec = u.pn >> 2, cs0 = (u.pn & 3) * 256 + 64 * wc + 8 * fq;
        const int row0 = u.pm * 256 + wr * 64 + fr;
        if (sec == 1 || sec == 2) {
            const float* gv = (sec == 1) ? gq : gk; const float sc = (sec == 1) ? QSCALE : 1.0f;
            bf16_t* O = (sec == 1) ? Q : Kb;
            f32x4 g4[2][2];
#pragma unroll
            for (int bj = 0; bj < 2; ++bj)
#pragma unroll
                for (int n = 0; n < 2; ++n) g4[bj][n] = *(const f32x4*)(gv + 32 * bj + 8 * fq + 4 * n) * sc;
#pragma unroll
            for (int ai = 0; ai < 2; ++ai)
#pragma unroll
                for (int m = 0; m < 4; ++m) {
                    float ss = 0.f;
#pragma unroll
                    for (int bj = 0; bj < 2; ++bj)
#pragma unroll
                        for (int n = 0; n < 2; ++n) { const f32x4 v = acc[ai][bj][m][n]; ss += (v[0] * v[0] + v[1] * v[1]) + (v[2] * v[2] + v[3] * v[3]); }
                    ss += __shfl_xor(ss, 16); ss += __shfl_xor(ss, 32);
                    const float rs = __builtin_amdgcn_rsqf(ss * (1.0f / 64.0f) + RMS_EPS);
                    bf16_t* rowp = O + (size_t)(row0 + ai * 128 + m * 16) * 1024 + cs0;
#pragma unroll
                    for (int bj = 0; bj < 2; ++bj) { const f32x4 v0 = acc[ai][bj][m][0] * rs * g4[bj][0], v1 = acc[ai][bj][m][1] * rs * g4[bj][1];
                        u32x4 w; w.x = cvt_pk_bf16(v0[0], v0[1]); w.y = cvt_pk_bf16(v0[2], v0[3]); w.z = cvt_pk_bf16(v1[0], v1[1]); w.w = cvt_pk_bf16(v1[2], v1[3]);
                        *(u32x4*)(rowp + bj * 32) = w; }
                }
        } else {
#pragma unroll
            for (int ai = 0; ai < 2; ++ai)
#pragma unroll
                for (int m = 0; m < 4; ++m) { const int row = row0 + ai * 128 + m * 16;
#pragma unroll
                    for (int bj = 0; bj < 2; ++bj) { const f32x4 v0 = acc[ai][bj][m][0], v1 = acc[ai][bj][m][1];
                        u32x4 w; w.x = cvt_pk_bf16(v0[0], v0[1]); w.y = cvt_pk_bf16(v0[2], v0[3]); w.z = cvt_pk_bf16(v1[0], v1[1]); w.w = cvt_pk_bf16(v1[2], v1[3]);
                        const int cs = cs0 + 32 * bj;
                        if (sec == 0) { const int b = row >> 13, t = row & 8191, gg = cs >> 4, j0 = cs & 15;
                            *(u32x4*)(UG + ((size_t)(b * NG + gg) * SEQ + t) * 16 + j0) = w; }
                        else *(u32x4*)(V + (size_t)row * 1024 + cs) = w; } }
        }
    }
};
struct EpiGlu {
    static constexpr int BMODE = 2;
    const bf16_t* Y; bf16_t* CAT; const float* bias;
    __device__ __forceinline__ void operator()(const f32x4 (&acc)[2][2][4][2], const pg8::Unit& u, int wr, int wc, int fr, int fq) const {
        const int c0 = u.pn * 256 + 64 * wc + 8 * fq, row0 = u.pm * 256 + wr * 64 + fr;
        f32x4 b4[2][2];
#pragma unroll
        for (int bj = 0; bj < 2; ++bj)
#pragma unroll
            for (int n = 0; n < 2; ++n) b4[bj][n] = *(const f32x4*)(bias + c0 + 32 * bj + 4 * n);
#pragma unroll
        for (int ai = 0; ai < 2; ++ai)
#pragma unroll
            for (int m = 0; m < 4; ++m) { const size_t row = (size_t)(row0 + ai * 128 + m * 16);
#pragma unroll
                for (int bj = 0; bj < 2; ++bj) { const int c = c0 + 32 * bj;
                    const u32x4 yv = *(const u32x4*)(Y + row * 1024 + c);
                    const f32x4 a0 = acc[ai][bj][m][0] + b4[bj][0], a1 = acc[ai][bj][m][1] + b4[bj][1];
                    float y[8] = {bflo(yv.x), bfhi(yv.x), bflo(yv.y), bfhi(yv.y), bflo(yv.z), bfhi(yv.z), bflo(yv.w), bfhi(yv.w)};
                    float z[8];
#pragma unroll
                    for (int j = 0; j < 8; ++j) { const float a = j < 4 ? a0[j & 3] : a1[j & 3]; z[j] = y[j] * __builtin_amdgcn_rcpf(1.0f + __builtin_amdgcn_exp2f(-1.4426950408889634f * a)); }
                    u32x4 w; w.x = cvt_pk_bf16(z[0], z[1]); w.y = cvt_pk_bf16(z[2], z[3]); w.z = cvt_pk_bf16(z[4], z[5]); w.w = cvt_pk_bf16(z[6], z[7]);
                    *(u32x4*)(CAT + row * 2048 + c) = w; } }
    }
};
struct EpiMlp1 {
    static constexpr int BMODE = 2;
    bf16_t* ACT; const float* rss; const float* bias2;
    __device__ __forceinline__ void operator()(const f32x4 (&acc)[2][2][4][2], const pg8::Unit& u, int wr, int wc, int fr, int fq) const {
        const int c0 = u.pn * 256 + 64 * wc + 8 * fq, row0 = u.pm * 256 + wr * 64 + fr;
        const int b = (u.pm * 256) >> 13;
        f32x4 b4[2][2];
#pragma unroll
        for (int bj = 0; bj < 2; ++bj)
#pragma unroll
            for (int n = 0; n < 2; ++n) b4[bj][n] = *(const f32x4*)(bias2 + (size_t)b * HID + c0 + 32 * bj + 4 * n);
#pragma unroll
        for (int ai = 0; ai < 2; ++ai)
#pragma unroll
            for (int m = 0; m < 4; ++m) { const int row = row0 + ai * 128 + m * 16; bf16_t* rowp = ACT + (size_t)row * HID + c0;
                const float rs = __builtin_amdgcn_rsqf(rss[row] * (1.0f / DM) + RMS_EPS);
#pragma unroll
                for (int bj = 0; bj < 2; ++bj) { f32x4 v0 = acc[ai][bj][m][0] * rs + b4[bj][0], v1 = acc[ai][bj][m][1] * rs + b4[bj][1];
#pragma unroll
                    for (int j = 0; j < 4; ++j) { const float a = fmaxf(v0[j], 0.f), bq = fmaxf(v1[j], 0.f); v0[j] = a * a; v1[j] = bq * bq; }
                    u32x4 w; w.x = cvt_pk_bf16(v0[0], v0[1]); w.y = cvt_pk_bf16(v0[2], v0[3]); w.z = cvt_pk_bf16(v1[0], v1[1]); w.w = cvt_pk_bf16(v1[2], v1[3]);
                    __builtin_nontemporal_store(w, (u32x4*)(rowp + bj * 32)); } }
    }
};
template <bool RSS> struct EpiResid {
    static constexpr int BMODE = 2;
    const float* base; float* out; const float* gate; float* rss; const float* gnorm; const float* scale; bf16_t* H; bf16_t* X1;
    __device__ __forceinline__ void operator()(const f32x4 (&acc)[2][2][4][2], const pg8::Unit& u, int wr, int wc, int fr, int fq) const {
        const int c0 = u.pn * 256 + 64 * wc + 8 * fq, row0 = u.pm * 256 + wr * 64 + fr;
        const int b = (u.pm * 256) >> 13;
        f32x4 g4[2][2], s4[2][2];
#pragma unroll
        for (int bj = 0; bj < 2; ++bj)
#pragma unroll
            for (int n = 0; n < 2; ++n) { g4[bj][n] = *(const f32x4*)(gate + (size_t)b * 12288 + c0 + 32 * bj + 4 * n);
                if (RSS) s4[bj][n] = *(const f32x4*)(gnorm + c0 + 32 * bj + 4 * n) * (*(const f32x4*)(scale + (size_t)b * 12288 + c0 + 32 * bj + 4 * n) + 1.0f); }
#pragma unroll
        for (int ai = 0; ai < 2; ++ai)
#pragma unroll
            for (int m = 0; m < 4; ++m) { const int row = row0 + ai * 128 + m * 16; const size_t off = (size_t)row * DM + c0; float ss = 0.f;
#pragma unroll
                for (int bj = 0; bj < 2; ++bj) {
                    f32x4 b0_, b1_;
                    if (RSS) { b0_ = __builtin_nontemporal_load((const f32x4*)(base + off + 32 * bj)); b1_ = __builtin_nontemporal_load((const f32x4*)(base + off + 32 * bj + 4)); }
                    else { const u32x4 xb = *(const u32x4*)(X1 + off + 32 * bj); b0_ = (f32x4){bflo(xb.x), bfhi(xb.x), bflo(xb.y), bfhi(xb.y)}; b1_ = (f32x4){bflo(xb.z), bfhi(xb.z), bflo(xb.w), bfhi(xb.w)}; }
                    const f32x4 o0 = b0_ + g4[bj][0] * acc[ai][bj][m][0], o1 = b1_ + g4[bj][1] * acc[ai][bj][m][1];
                    if (RSS) { u32x4 xw; xw.x = cvt_pk_bf16(o0[0], o0[1]); xw.y = cvt_pk_bf16(o0[2], o0[3]); xw.z = cvt_pk_bf16(o1[0], o1[1]); xw.w = cvt_pk_bf16(o1[2], o1[3]); *(u32x4*)(X1 + off + 32 * bj) = xw; }
                    else { *(f32x4*)(out + off + 32 * bj) = o0; *(f32x4*)(out + off + 32 * bj + 4) = o1; }
                    if (RSS) { ss += (o0[0] * o0[0] + o0[1] * o0[1]) + (o0[2] * o0[2] + o0[3] * o0[3]) + (o1[0] * o1[0] + o1[1] * o1[1]) + (o1[2] * o1[2] + o1[3] * o1[3]);
                        const f32x4 h0 = o0 * s4[bj][0], h1 = o1 * s4[bj][1];
                        u32x4 w; w.x = cvt_pk_bf16(h0[0], h0[1]); w.y = cvt_pk_bf16(h0[2], h0[3]); w.z = cvt_pk_bf16(h1[0], h1[1]); w.w = cvt_pk_bf16(h1[2], h1[3]);
                        *(u32x4*)(H + off + 32 * bj) = w; } }
                if (RSS) { ss += __shfl_xor(ss, 16); ss += __shfl_xor(ss, 32); if (fq == 0) atomicAdd(rss + row, ss); } }
    }
};

namespace att {
constexpr int SLOT = 32768, NSLOT = 4, OFF_V = 16384, RING = NSLOT * SLOT, OFF_WSF = RING, XPAIR = 17408;
__device__ __forceinline__ int crow(int r, int hi) { return (r & 3) + 8 * (r >> 2) + 4 * hi; }
__device__ __forceinline__ void glds16(const void* gsrc, unsigned lds_dst) { unsigned keep;
    asm volatile("s_mov_b32 %0, m0\n\ts_mov_b32 m0, %2\n\ts_nop 0\n\tglobal_load_lds_dwordx4 %1, off\n\ts_mov_b32 m0, %0" : "=&s"(keep) : "v"(gsrc), "s"(lds_dst) : "memory"); }
__device__ __forceinline__ s16x4 vtr(const LAS char* p) { return __builtin_bit_cast(s16x4, __builtin_amdgcn_ds_read_tr16_b64_v4i16((LAS s16x4*)p)); }
__device__ __forceinline__ float swap_max(float m) { auto rr = __builtin_amdgcn_permlane32_swap(__float_as_uint(m), __float_as_uint(m), false, false); return fmaxf(__uint_as_float(rr[0]), __uint_as_float(rr[1])); }
__device__ __forceinline__ float swap_sum(float m) { auto rr = __builtin_amdgcn_permlane32_swap(__float_as_uint(m), __float_as_uint(m), false, false); return __uint_as_float(rr[0]) + __uint_as_float(rr[1]); }
#define ATT_WAIT_BAR(N) asm volatile("s_waitcnt vmcnt(" #N ") lgkmcnt(0)\n\ts_barrier" ::: "memory")
#define ATT_LBAR() asm volatile("s_waitcnt lgkmcnt(0)\n\ts_barrier" ::: "memory")

template <bool QK, bool PV, bool NS>
__device__ __forceinline__ void att_step(const LAS char* kp, const int (&koff)[4], const LAS char* vp, const bf16x8 (&qr)[4], f32x16& negm, float& mhat, float& l_reg,
                                         f32x16 (&o)[4], u32x4 (&pw)[4], f32x16& p0, f32x16& p1, LAS float* wsf, int r32, int hi) {
    if (QK) {
        bf16x8 kf[8];
#pragma unroll
        for (int d0 = 0; d0 < 4; ++d0) { kf[2 * d0] = *(const LAS bf16x8*)(kp + koff[d0]); kf[2 * d0 + 1] = *(const LAS bf16x8*)(kp + koff[d0] + 4096); }
        asm volatile("" ::: "memory");
        p0 = __builtin_amdgcn_mfma_f32_32x32x16_bf16(kf[0], qr[0], NS ? f32x16{} : negm, 0, 0, 0); p1 = __builtin_amdgcn_mfma_f32_32x32x16_bf16(kf[1], qr[0], NS ? f32x16{} : negm, 0, 0, 0);
#pragma unroll
        for (int d0 = 1; d0 < 4; ++d0) { p0 = __builtin_amdgcn_mfma_f32_32x32x16_bf16(kf[2 * d0], qr[d0], p0, 0, 0, 0); p1 = __builtin_amdgcn_mfma_f32_32x32x16_bf16(kf[2 * d0 + 1], qr[d0], p1, 0, 0, 0); }
    }
    bf16x8 vc[4];
    if (PV) {
#pragma unroll
        for (int d = 0; d < 4; ++d) { const s16x4 lo = vtr(vp + d * 4096), hh = vtr(vp + d * 4096 + 512); vc[d] = (bf16x8){lo[0], lo[1], lo[2], lo[3], hh[0], hh[1], hh[2], hh[3]}; }
    }
    __builtin_amdgcn_sched_barrier(0);
#pragma unroll
    for (int ks = 0; ks < 4; ++ks) {
        bf16x8 vn[4];
#pragma unroll
        for (int d = 0; d < 4; ++d) {
            if (PV) {
                if (ks < 3) { const s16x4 lo = vtr(vp + d * 4096 + (ks + 1) * 1024), hh = vtr(vp + d * 4096 + (ks + 1) * 1024 + 512); vn[d] = (bf16x8){lo[0], lo[1], lo[2], lo[3], hh[0], hh[1], hh[2], hh[3]}; }
                o[d] = __builtin_amdgcn_mfma_f32_32x32x16_bf16(__builtin_bit_cast(bf16x8, pw[ks]), vc[d], o[d], 0, 0, 0);
            }
            if (QK) { const int e = ks * 4 + d; p0[e] = __builtin_amdgcn_exp2f(p0[e]); p1[e] = __builtin_amdgcn_exp2f(p1[e]); }
            __builtin_amdgcn_sched_barrier(0);
        }
        if (PV && ks < 3) {
#pragma unroll
            for (int d = 0; d < 4; ++d) vc[d] = vn[d];
        }
    }
    if (QK && !NS) {
        float mx[8];
#pragma unroll
        for (int r = 0; r < 8; ++r) mx[r] = fmaxf(fmaxf(p0[r], p0[r + 8]), fmaxf(p1[r], p1[r + 8]));
        float rm = fmaxf(fmaxf(fmaxf(mx[0], mx[1]), fmaxf(mx[2], mx[3])), fmaxf(fmaxf(mx[4], mx[5]), fmaxf(mx[6], mx[7])));
        rm = swap_max(rm);
        if (__any(rm > 256.0f)) {
            const float dl = fmaxf(__builtin_amdgcn_logf(rm), 0.f); mhat += dl;
            const float f = __builtin_amdgcn_exp2f(-dl); l_reg *= f;
#pragma unroll
            for (int r = 0; r < 16; ++r) { p0[r] *= f; p1[r] *= f; negm[r] = -mhat; }
            if (hi == 0) wsf[r32] = f;
#pragma unroll
            for (int r = 0; r < 16; ++r) { const float fr_ = wsf[crow(r, hi)];
#pragma unroll
                for (int d = 0; d < 4; ++d) o[d][r] *= fr_; }
        }
    }
    if (QK) {
        float sacc = 0.f;
#pragma unroll
        for (int r = 0; r < 16; ++r) sacc += p0[r] + p1[r];
        l_reg += sacc;
#pragma unroll
        for (int j = 0; j < 4; ++j) { pw[0][j] = cvt_pk_bf16(p0[2 * j], p0[2 * j + 1]); pw[1][j] = cvt_pk_bf16(p0[8 + 2 * j], p0[8 + 2 * j + 1]);
                                      pw[2][j] = cvt_pk_bf16(p1[2 * j], p1[2 * j + 1]); pw[3][j] = cvt_pk_bf16(p1[8 + 2 * j], p1[8 + 2 * j + 1]); }
    }
}

__device__ __forceinline__ void att_first_ns(const LAS char* kp, const int (&koff)[4], const bf16x8 (&qr)[4], f32x16& n0, f32x16& n1) {
    bf16x8 kf[8];
#pragma unroll
    for (int d0 = 0; d0 < 4; ++d0) { kf[2 * d0] = *(const LAS bf16x8*)(kp + koff[d0]); kf[2 * d0 + 1] = *(const LAS bf16x8*)(kp + koff[d0] + 4096); }
    n0 = __builtin_amdgcn_mfma_f32_32x32x16_bf16(kf[0], qr[0], f32x16{}, 0, 0, 0); n1 = __builtin_amdgcn_mfma_f32_32x32x16_bf16(kf[1], qr[0], f32x16{}, 0, 0, 0);
#pragma unroll
    for (int d0 = 1; d0 < 4; ++d0) { n0 = __builtin_amdgcn_mfma_f32_32x32x16_bf16(kf[2 * d0], qr[d0], n0, 0, 0, 0); n1 = __builtin_amdgcn_mfma_f32_32x32x16_bf16(kf[2 * d0 + 1], qr[d0], n1, 0, 0, 0); }
#pragma unroll
    for (int r = 0; r < 16; ++r) { n0[r] = __builtin_amdgcn_exp2f(n0[r]); n1[r] = __builtin_amdgcn_exp2f(n1[r]); }
}
template <bool QK, bool PV>
__device__ __forceinline__ void att_step_ns(const LAS char* kp, const int (&koff)[4], const LAS char* vp, const bf16x8 (&qr)[4], float& l_reg,
                                            f32x16 (&o)[4], u32x4 (&pw)[4], f32x16& c0, f32x16& c1, f32x16& n0, f32x16& n1) {
#define ATT_KFRAG(g) (*(const LAS bf16x8*)(kp + koff[(g) >> 1] + ((g) & 1) * 4096))
    bf16x8 kr[4];
    if (QK) { kr[0] = ATT_KFRAG(0); kr[1] = ATT_KFRAG(1); kr[2] = ATT_KFRAG(2); kr[3] = ATT_KFRAG(3); }
    __builtin_amdgcn_sched_barrier(0);
    float sacc = 0.f;
#pragma unroll
    for (int g = 0; g < 8; ++g) {
        {   const int w = g >> 1, idx = (w & 1) * 8 + 4 * (g & 1);
            float v0, v1, v2, v3;
            if (w < 2) { v0 = c0[idx]; v1 = c0[idx + 1]; v2 = c0[idx + 2]; v3 = c0[idx + 3]; } else { v0 = c1[idx]; v1 = c1[idx + 1]; v2 = c1[idx + 2]; v3 = c1[idx + 3]; }
            pw[w][2 * (g & 1)] = cvt_pk_bf16(v0, v1); pw[w][2 * (g & 1) + 1] = cvt_pk_bf16(v2, v3);
            sacc += (v0 + v1) + (v2 + v3);
        }
        if (QK) { const int d0 = g >> 1;
            if ((g & 1) == 0) n0 = __builtin_amdgcn_mfma_f32_32x32x16_bf16(kr[g & 3], qr[d0], d0 == 0 ? f32x16{} : n0, 0, 0, 0);
            else              n1 = __builtin_amdgcn_mfma_f32_32x32x16_bf16(kr[g & 3], qr[d0], d0 == 0 ? f32x16{} : n1, 0, 0, 0);
            if (g + 4 < 8) kr[g & 3] = ATT_KFRAG(g + 4); }
        __builtin_amdgcn_sched_barrier(0);
    }
#undef ATT_KFRAG
    l_reg += sacc;
#define ATT_VFRAG(dst, i) do { const s16x4 lo_ = vtr(vp + ((i) & 3) * 4096 + ((i) >> 2) * 1024), hh_ = vtr(vp + ((i) & 3) * 4096 + ((i) >> 2) * 1024 + 512); \
        dst = (bf16x8){lo_[0], lo_[1], lo_[2], lo_[3], hh_[0], hh_[1], hh_[2], hh_[3]}; } while (0)
    bf16x8 vr[4];
    if (PV) { ATT_VFRAG(vr[0], 0); ATT_VFRAG(vr[1], 1); ATT_VFRAG(vr[2], 2); ATT_VFRAG(vr[3], 3); }
    __builtin_amdgcn_sched_barrier(0);
#pragma unroll
    for (int i = 0; i < 16; ++i) {
        if (PV) {
            o[i & 3] = __builtin_amdgcn_mfma_f32_32x32x16_bf16(__builtin_bit_cast(bf16x8, pw[i >> 2]), vr[i & 3], o[i & 3], 0, 0, 0);
            if (i + 4 < 16) ATT_VFRAG(vr[i & 3], i + 4);
        }
        if (QK) { n0[i] = __builtin_amdgcn_exp2f(n0[i]); n1[i] = __builtin_amdgcn_exp2f(n1[i]); }
        __builtin_amdgcn_sched_barrier(0);
    }
#undef ATT_VFRAG
}

template <bool NS> __device__ __forceinline__ void unit(int b, int h, int qb, const bf16_t* Q, const bf16_t* K, const bf16_t* V, bf16_t* CAT, LAS char* lds, float lam, const float* gsub) {
    const int tid = threadIdx.x, lane = tid & 63, r32 = lane & 31, hi = lane >> 5; const int wid = __builtin_amdgcn_readfirstlane(tid >> 6);
    const int c = wid >> 2, rq = wid & 3;
    const long rowbase = (long)b * SEQ; const int q0 = qb * 128;
    const bf16_t* Qw = Q + (rowbase + q0 + rq * 32) * 1024 + h * 128 + c * 64;
    const bf16_t* Kh = K + rowbase * 1024 + h * 128; const bf16_t* Vh = V + rowbase * 1024 + h * 128;
    const unsigned lds0 = (unsigned)(uintptr_t)lds;
    const bf16_t* ksrc = Kh + (long)(8 * wid + (lane >> 3)) * 1024 + (((lane & 7) ^ (lane >> 3)) * 8);
    const bf16_t* vsrc = Vh + (long)(16 * (wid & 3) + (lane >> 2)) * 1024 + (wid >> 2) * 32 + (lane & 3) * 8;
    const unsigned dK0 = lds0 + wid * 1024, dK1 = lds0 + 8192 + wid * 1024, dV0 = lds0 + OFF_V + wid * 1024, dV1 = lds0 + OFF_V + (wid + 8) * 1024;
#define ATT_DMA(t, slot) do { const long to_ = (long)(t) * 64 * 1024; const unsigned so_ = (unsigned)(slot); \
        glds16(ksrc + to_, (unsigned)__builtin_amdgcn_readfirstlane(dK0 + so_)); glds16(ksrc + to_ + 64, (unsigned)__builtin_amdgcn_readfirstlane(dK1 + so_)); \
        glds16(vsrc + to_, (unsigned)__builtin_amdgcn_readfirstlane(dV0 + so_)); glds16(vsrc + to_ + 64, (unsigned)__builtin_amdgcn_readfirstlane(dV1 + so_)); } while (0)
    const int NT = 2 * qb + 2, my_nt = NT - (rq < 2 ? 1 : 0);
    ATT_DMA(0, 0); ATT_DMA(1, SLOT); ATT_DMA((NT > 2) ? 2 : 1, 2 * SLOT);
    bf16x8 qr[4];
#pragma unroll
    for (int d0 = 0; d0 < 4; ++d0) qr[d0] = *reinterpret_cast<const bf16x8*>(&Qw[(long)r32 * 1024 + d0 * 16 + hi * 8]);
    asm volatile("" : "+v"(qr[0]), "+v"(qr[1]), "+v"(qr[2]), "+v"(qr[3]));
    LAS float* wsf = (LAS float*)(lds + OFF_WSF) + wid * 64;
    const LAS char* kp0 = lds + c * 8192 + r32 * 128;
    int koff[4];
#pragma unroll
    for (int d0 = 0; d0 < 4; ++d0) koff[d0] = ((2 * d0 + hi) ^ (r32 & 7)) * 16;
    const LAS char* vp0 = lds + OFF_V + ((lane >> 4) & 1) * 32 + (lane & 3) * 8 + (4 * hi + ((lane & 15) >> 2)) * 64;
    float mhat = 0.f, l_reg = 0.f; f32x16 o[4]; f32x16 negm = f32x16{}, p0 = f32x16{}, p1 = f32x16{}; u32x4 pw[4];
#pragma unroll
    for (int d = 0; d < 4; ++d) o[d] = f32x16{};
#pragma unroll
    for (int j = 0; j < 4; ++j) pw[j] = (u32x4){0u, 0u, 0u, 0u};
    ATT_WAIT_BAR(0);
    if (NS) {
        f32x16 q0, q1;
        att_first_ns(kp0, koff, qr, p0, p1);
        int slot = 0, t = 0;
#define ATT_STEP(C0, C1, N0, N1) do { \
            ATT_WAIT_BAR(4); \
            { const int s3 = (slot >= SLOT) ? slot - SLOT : slot + 3 * SLOT; const int tt = (t + 3 < NT) ? t + 3 : NT - 1; ATT_DMA(tt, s3); } \
            const int nslot = (slot == 3 * SLOT) ? 0 : slot + SLOT; \
            att_step_ns<true, true>(kp0 + nslot, koff, vp0 + slot, qr, l_reg, o, pw, C0, C1, N0, N1); \
            slot = nslot; ++t; } while (0)
        for (int i = 0; i < qb; ++i) { ATT_STEP(p0, p1, q0, q1); ATT_STEP(q0, q1, p0, p1); }
        ATT_STEP(p0, p1, q0, q1);
#undef ATT_STEP
        if (rq >= 2) att_step_ns<false, true>(kp0, koff, vp0 + slot, qr, l_reg, o, pw, q0, q1, p0, p1);
    } else {
    att_step<true, false, NS>(kp0, koff, vp0, qr, negm, mhat, l_reg, o, pw, p0, p1, wsf, r32, hi);
    int slot = 0;
    for (int t = 0; t < NT; ++t) {
        if (t >= 1) { if (t + 2 < NT) { ATT_WAIT_BAR(4); } else { ATT_WAIT_BAR(0); } }
        if (t + 3 < NT) { const int s3 = (slot >= SLOT) ? slot - SLOT : slot + 3 * SLOT; ATT_DMA(t + 3, s3); }
        const int nslot = (slot == 3 * SLOT) ? 0 : slot + SLOT;
        if (t + 1 < my_nt) att_step<true, true, NS>(kp0 + nslot, koff, vp0 + slot, qr, negm, mhat, l_reg, o, pw, p0, p1, wsf, r32, hi);
        else if (t < my_nt) att_step<false, true, NS>(kp0 + nslot, koff, vp0 + slot, qr, negm, mhat, l_reg, o, pw, p0, p1, wsf, r32, hi);
        slot = nslot;
    }
    }
    l_reg = swap_sum(l_reg);
    if (hi == 0) wsf[32 + r32] = l_reg;
#pragma unroll
    for (int r = 0; r < 16; ++r) { const float rl = __builtin_amdgcn_rcpf(wsf[32 + crow(r, hi)]);
#pragma unroll
        for (int d = 0; d < 4; ++d) o[d][r] *= rl; }
    ATT_WAIT_BAR(0);
    LAS float* xf = (LAS float*)(lds + rq * XPAIR);
    if (c == 1) {
#pragma unroll
        for (int d = 0; d < 4; ++d)
#pragma unroll
            for (int r = 0; r < 16; ++r) xf[(d * 16 + r) * 64 + lane] = o[d][r];
    }
    ATT_WAIT_BAR(0);
    if (c == 0) {
#pragma unroll
        for (int d = 0; d < 4; ++d)
#pragma unroll
            for (int r = 0; r < 16; ++r) o[d][r] -= lam * xf[(d * 16 + r) * 64 + lane];
        asm volatile("s_waitcnt lgkmcnt(0)" ::: "memory");
#pragma unroll
        for (int d = 0; d < 4; ++d)
#pragma unroll
            for (int r = 0; r < 16; ++r) xf[crow(r, hi) * 132 + d * 32 + r32] = o[d][r];
        asm volatile("s_waitcnt lgkmcnt(0)" ::: "memory");
        const int row = lane >> 1, half = lane & 1;
        f32x4 v[16]; float ss = 0.f;
#pragma unroll
        for (int i = 0; i < 16; ++i) { v[i] = *(const LAS f32x4*)(xf + row * 132 + half * 64 + i * 4); ss += (v[i][0] * v[i][0] + v[i][1] * v[i][1]) + (v[i][2] * v[i][2] + v[i][3] * v[i][3]); }
        ss += __shfl_xor(ss, 1);
        const float rs = __builtin_amdgcn_rsqf(ss * (1.0f / 128.0f) + RMS_EPS) * (1.0f - LAMBDA_INIT);
        bf16_t* op = CAT + (size_t)(rowbase + q0 + rq * 32 + row) * 2048 + 1024 + h * 128 + half * 64;
#pragma unroll
        for (int i = 0; i < 8; ++i) { const f32x4 g0 = *(const f32x4*)(gsub + half * 64 + i * 8), g1 = *(const f32x4*)(gsub + half * 64 + i * 8 + 4);
            const f32x4 a = v[2 * i] * rs * g0, bq = v[2 * i + 1] * rs * g1;
            u32x4 w; w.x = cvt_pk_bf16(a[0], a[1]); w.y = cvt_pk_bf16(a[2], a[3]); w.z = cvt_pk_bf16(bq[0], bq[1]); w.w = cvt_pk_bf16(bq[2], bq[3]);
            *(u32x4*)(op + i * 8) = w; }
    }
    ATT_WAIT_BAR(0);
#undef ATT_DMA
}
}

namespace ssm {
constexpr int TROW = 132, TILE_BYTES = 32 * TROW * 4;
constexpr int OFF_SEG = 8 * TILE_BYTES;
__device__ __forceinline__ int crow(int r, int hi) { return (r & 3) + 8 * (r >> 2) + 4 * hi; }
__device__ __forceinline__ void item(int b, int g, const bf16_t* UG, bf16_t* YS, const float* AV, const float* A1K, const bf16_t* BB, const bf16_t* CM, const float* dvec, LAS char* lds) {
    const int tid = threadIdx.x, lane = tid & 63, r32 = lane & 31, hi = lane >> 5; const int wid = __builtin_amdgcn_readfirstlane(tid >> 6);
    const int bg = b * NG + g;
    bf16x8 bfr[4], cfr[4];
#pragma unroll
    for (int nt = 0; nt < 4; ++nt) bfr[nt] = *(const bf16x8*)(BB + ((size_t)(g * 128 + nt * 32 + r32) * 16 + 8 * hi));
#pragma unroll
    for (int s = 0; s < 4; ++s) cfr[s] = *(const bf16x8*)(CM + ((size_t)(g * 16 + (lane & 15)) * 128 + 32 * s + 8 * (lane >> 4)));
    const float ar = AV[(g * 64 + lane) * 2], ai = AV[(g * 64 + lane) * 2 + 1];
    const float kr = A1K[(g * 64 + lane) * 2], ki = A1K[(g * 64 + lane) * 2 + 1];
    bf16x8 dfr;
    { const float dq = dvec[g * 16 + (lane & 15)]; const short db = (short)f2bf(dq);
#pragma unroll
      for (int j = 0; j < 8; ++j) dfr[j] = (8 * (lane >> 4) + j == (lane & 15)) ? db : (short)0; }
    LAS float* T = (LAS float*)(lds + wid * TILE_BYTES);
    LAS float* SEG = (LAS float*)(lds + OFF_SEG);
    const bf16_t* Ub = UG + (size_t)bg * SEQ * 16;
    const int tseg = wid * 1024;
    float hr = 0.f, him = 0.f;
    {
        const float aAr = AV[(g * 64 + r32) * 2], aAi = AV[(g * 64 + r32) * 2 + 1], aBr = AV[(g * 64 + 32 + r32) * 2], aBi = AV[(g * 64 + 32 + r32) * 2 + 1];
        float pAr = aAr, pAi = aAi, pBr = aBr, pBi = aBi;
#pragma unroll
        for (int i = 0; i < 4; ++i) { const float nr = pAr * pAr - pAi * pAi, ni = 2.0f * pAr * pAi; pAr = nr; pAi = ni; const float mr = pBr * pBr - pBi * pBi, mi = 2.0f * pBr * pBi; pBr = mr; pBi = mi; }
        const int tokperm = (r32 & 3) + 4 * (r32 >> 3) + 16 * ((r32 >> 2) & 1);
        float cAr = 0.f, cAi = 0.f, cBr = 0.f, cBi = 0.f;
        for (int tile = 0; tile < 32; ++tile) {
            const int t0 = tseg + tile * 32;
            const bf16x8 ufr = *(const bf16x8*)(Ub + (size_t)(t0 + tokperm) * 16 + 8 * hi);
            f32x16 ac[4];
#pragma unroll
            for (int nt = 0; nt < 4; ++nt) ac[nt] = __builtin_amdgcn_mfma_f32_32x32x16_bf16(ufr, bfr[nt], f32x16{}, 0, 0, 0);
            float sAr = 0.f, sAi = 0.f, sBr = 0.f, sBi = 0.f;
#pragma unroll
            for (int r = 0; r < 16; ++r) {
                const float nr = fmaf(aAr, sAr, fmaf(-aAi, sAi, ac[0][r])), ni = fmaf(aAr, sAi, fmaf(aAi, sAr, ac[2][r])); sAr = nr; sAi = ni;
                const float mr = fmaf(aBr, sBr, fmaf(-aBi, sBi, ac[1][r])), mi = fmaf(aBr, sBi, fmaf(aBi, sBr, ac[3][r])); sBr = mr; sBi = mi; }
            const float oAr = __shfl_xor(sAr, 32), oAi = __shfl_xor(sAi, 32), oBr = __shfl_xor(sBr, 32), oBi = __shfl_xor(sBi, 32);
            const float l0Ar = hi ? oAr : sAr, l0Ai = hi ? oAi : sAi, l1Ar = hi ? sAr : oAr, l1Ai = hi ? sAi : oAi;
            const float l0Br = hi ? oBr : sBr, l0Bi = hi ? oBi : sBi, l1Br = hi ? sBr : oBr, l1Bi = hi ? sBi : oBi;
            { const float tr = l0Ar + pAr * cAr - pAi * cAi, ti = l0Ai + pAr * cAi + pAi * cAr; cAr = l1Ar + pAr * tr - pAi * ti; cAi = l1Ai + pAr * ti + pAi * tr; }
            { const float tr = l0Br + pBr * cBr - pBi * cBi, ti = l0Bi + pBr * cBi + pBi * cBr; cBr = l1Br + pBr * tr - pBi * ti; cBi = l1Bi + pBr * ti + pBi * tr; }
        }
        if (hi == 0) { SEG[(wid * 64 + r32) * 2] = cAr; SEG[(wid * 64 + r32) * 2 + 1] = cAi; SEG[(wid * 64 + 32 + r32) * 2] = cBr; SEG[(wid * 64 + 32 + r32) * 2 + 1] = cBi; }
        __syncthreads();
        float cr = 0.f, ci = 0.f;
        for (int s = 0; s < wid; ++s) { const float sr = SEG[(s * 64 + lane) * 2], si = SEG[(s * 64 + lane) * 2 + 1];
            const float nr = kr * cr - ki * ci + sr, ni = kr * ci + ki * cr + si; cr = nr; ci = ni; }
        hr = cr; him = ci;
        cAr = __shfl(hr, r32); cAi = __shfl(him, r32); cBr = __shfl(hr, 32 + r32); cBi = __shfl(him, 32 + r32);
        for (int tile = 0; tile < 32; ++tile) {
            const int t0 = tseg + tile * 32;
            const bf16x8 ufr = *(const bf16x8*)(Ub + (size_t)(t0 + tokperm) * 16 + 8 * hi);
            f32x16 ac[4];
#pragma unroll
            for (int nt = 0; nt < 4; ++nt) ac[nt] = __builtin_amdgcn_mfma_f32_32x32x16_bf16(ufr, bfr[nt], f32x16{}, 0, 0, 0);
            float sAr = 0.f, sAi = 0.f, sBr = 0.f, sBi = 0.f;
#pragma unroll
            for (int r = 0; r < 16; ++r) {
                const float nr = fmaf(aAr, sAr, fmaf(-aAi, sAi, ac[0][r])), ni = fmaf(aAr, sAi, fmaf(aAi, sAr, ac[2][r])); sAr = nr; sAi = ni;
                const float mr = fmaf(aBr, sBr, fmaf(-aBi, sBi, ac[1][r])), mi = fmaf(aBr, sBi, fmaf(aBi, sBr, ac[3][r])); sBr = mr; sBi = mi; }
            const float l0Ar = __shfl(sAr, r32), l0Ai = __shfl(sAi, r32), l0Br = __shfl(sBr, r32), l0Bi = __shfl(sBi, r32);
            float hAr = hi ? l0Ar + pAr * cAr - pAi * cAi : cAr, hAi = hi ? l0Ai + pAr * cAi + pAi * cAr : cAi;
            float hBr = hi ? l0Br + pBr * cBr - pBi * cBi : cBr, hBi = hi ? l0Bi + pBr * cBi + pBi * cBr : cBi;
#pragma unroll
            for (int r = 0; r < 16; ++r) {
                const float nr = fmaf(aAr, hAr, fmaf(-aAi, hAi, ac[0][r])), ni = fmaf(aAr, hAi, fmaf(aAi, hAr, ac[2][r])); hAr = nr; hAi = ni;
                const float mr = fmaf(aBr, hBr, fmaf(-aBi, hBi, ac[1][r])), mi = fmaf(aBr, hBi, fmaf(aBi, hBr, ac[3][r])); hBr = mr; hBi = mi;
                ((LAS unsigned*)T)[(16 * hi + r) * TROW + r32] = cvt_pk_bf16(hAr, hAi);
                ((LAS unsigned*)T)[(16 * hi + r) * TROW + 32 + r32] = cvt_pk_bf16(hBr, hBi); }
            cAr = __shfl(hAr, 32 + r32); cAi = __shfl(hAi, 32 + r32); cBr = __shfl(hBr, 32 + r32); cBi = __shfl(hBi, 32 + r32);
            asm volatile("s_waitcnt lgkmcnt(0)" ::: "memory");
#pragma unroll
            for (int mt = 0; mt < 2; ++mt) {
                f32x4 ya = (f32x4){0.f, 0.f, 0.f, 0.f};
                { bf16x8 uf = *(const bf16x8*)(Ub + (size_t)(t0 + mt * 16 + (lane & 15)) * 16 + 8 * ((lane >> 4) & 1));
                  if (lane >= 32) uf = (bf16x8){0, 0, 0, 0, 0, 0, 0, 0};
                  ya = __builtin_amdgcn_mfma_f32_16x16x32_bf16(uf, dfr, ya, 0, 0, 0); }
#pragma unroll
                for (int s = 0; s < 4; ++s) { const bf16x8 af = *(const LAS bf16x8*)((const LAS char*)T + (mt * 16 + (lane & 15)) * (TROW * 4) + (32 * s + 8 * (lane >> 4)) * 2);
                    ya = __builtin_amdgcn_mfma_f32_16x16x32_bf16(af, cfr[s], ya, 0, 0, 0); }
#pragma unroll
                for (int rg = 0; rg < 4; ++rg) { const int tl = mt * 16 + 4 * (lane >> 4) + rg;
                    *(LAS unsigned short*)((LAS char*)T + tl * (TROW * 4) + 256 + 2 * (lane & 15)) = f2bf(gelu_f(ya[rg])); }
            }
            asm volatile("s_waitcnt lgkmcnt(0)" ::: "memory");
            { const int tl = lane >> 1, half = lane & 1;
              const u32x4 yv = *(const LAS u32x4*)((const LAS char*)T + tl * (TROW * 4) + 256 + half * 16);
              *(u32x4*)(YS + (size_t)(b * SEQ + t0 + tl) * 1024 + g * 16 + half * 8) = yv; }
            asm volatile("s_waitcnt lgkmcnt(0)" ::: "memory");
        }
    }
    __syncthreads();
}
}

__device__ __forceinline__ void transpose_item(const float* W, int K, int N, bf16_t* WT, LAS float* scr, int item, int lane) {
    const int nblk = N / 32, kb = item / nblk, nb = item % nblk, k0 = 64 * kb, n0 = 32 * nb;
#pragma unroll 8
    for (int i = 0; i < 32; ++i) { const int kk = 2 * i + (lane >> 5); scr[kk * 33 + (lane & 31)] = __builtin_nontemporal_load(W + (size_t)(k0 + kk) * N + n0 + (lane & 31)); }
    asm volatile("s_waitcnt lgkmcnt(0)" ::: "memory");
    const int c = lane & 7;
#pragma unroll
    for (int j = 0; j < 4; ++j) { const int n = (lane >> 3) + 8 * j; const LAS float* s = scr + (8 * c) * 33 + n;
        u32x4 o; o.x = cvt_pk_bf16(s[0 * 33], s[1 * 33]); o.y = cvt_pk_bf16(s[2 * 33], s[3 * 33]); o.z = cvt_pk_bf16(s[4 * 33], s[5 * 33]); o.w = cvt_pk_bf16(s[6 * 33], s[7 * 33]);
        *(u32x4*)(WT + (size_t)(n0 + n) * K + k0 + 8 * c) = o; }
    asm volatile("s_waitcnt lgkmcnt(0)" ::: "memory");
}

__device__ __forceinline__ void norm_row(const float* xrow, bf16_t* orow, const float* gvec, const float* scale, const float* shift, float ssq_in, bool have, int lane) {
    const f32x4* xr = (const f32x4*)xrow + lane;
    f32x4 v[8]; float s = 0.f;
#pragma unroll
    for (int j = 0; j < 8; ++j) { v[j] = __builtin_nontemporal_load(xr + 64 * j); s += (v[j][0] * v[j][0] + v[j][1] * v[j][1]) + (v[j][2] * v[j][2] + v[j][3] * v[j][3]); }
    const float ssq = have ? ssq_in : wave_sum(s);
    const float rs = __builtin_amdgcn_rsqf(ssq * (1.0f / DM) + RMS_EPS);
    u32x2* o8 = (u32x2*)orow + lane;
#pragma unroll
    for (int j = 0; j < 8; ++j) { const f32x4 g4 = ((const f32x4*)gvec)[lane + 64 * j], sc = ((const f32x4*)scale)[lane + 64 * j], sh = ((const f32x4*)shift)[lane + 64 * j];
        const f32x4 h = v[j] * rs * g4 * (sc + 1.0f) + sh;
        u32x2 w; w.x = cvt_pk_bf16(h[0], h[1]); w.y = cvt_pk_bf16(h[2], h[3]); o8[64 * j] = w; }
}

#define XB_TMO      128
#define XB_XCNT(j)  (256  + 64 * (j))
#define XB_XSUB(j)  (1280 + 64 * (j))
#define XB_XGEN(j)  (2304 + 64 * (j))
#define XB_TOP      3328
#define XB_TOPGEN   3392
#define XB_SPIN_CAP (1u << 22)
__device__ __forceinline__ unsigned xb_ld(unsigned* p)              { return __hip_atomic_load(p, __ATOMIC_RELAXED, __HIP_MEMORY_SCOPE_AGENT); }
__device__ __forceinline__ unsigned xb_add(unsigned* p, unsigned v) { return __hip_atomic_fetch_add(p, v, __ATOMIC_RELAXED, __HIP_MEMORY_SCOPE_AGENT); }
__device__ __forceinline__ unsigned xb_xcc_id() { return (unsigned)__builtin_amdgcn_s_getreg((3 << 11) | 20) & 0xFu; }
#define XB_SPIN(cond, bar) do { unsigned _sp = 0; while (cond) { __builtin_amdgcn_s_sleep(1); \
    if ((++_sp & 255u) == 0u) { if (xb_ld(&(bar)[XB_TMO])) break; if (_sp > XB_SPIN_CAP) { atomicAdd(&(bar)[XB_TMO], 1u); break; } } } } while (0)
struct XcdBarrier { unsigned* bar; unsigned x; volatile LAS unsigned* st; };
__device__ __forceinline__ XcdBarrier xcd_barrier_post(unsigned* bar, volatile LAS unsigned* st) {
    XcdBarrier b; b.bar = bar; b.x = xb_xcc_id(); b.st = st;
    if (threadIdx.x == 0) (void)xb_add(&bar[XB_XCNT(b.x)], 1u);
    return b;
}
__device__ __forceinline__ void xcd_barrier_complete(unsigned* bar, unsigned x, unsigned& nloc, unsigned& nx) {
    const unsigned G = gridDim.x * gridDim.y * gridDim.z;
    unsigned sum, cnt, mine, sp = 0u;
    for (;;) {
        sum = 0u; cnt = 0u; mine = 0u;
#pragma unroll
        for (unsigned j = 0; j < 16; ++j) { const unsigned c = xb_ld(&bar[XB_XCNT(j)]); sum += c; cnt += (c > 0u) ? 1u : 0u; mine = (j == x) ? c : mine; }
        if (sum == G) break;
        __builtin_amdgcn_s_sleep(1);
        if ((++sp & 255u) == 0u) { if (xb_ld(&bar[XB_TMO])) break; if (sp > XB_SPIN_CAP) { atomicAdd(&bar[XB_TMO], 1u); break; } }
    }
    nloc = mine > 0u ? mine : 1u; nx = cnt > 0u ? cnt : 1u;
}
__device__ __forceinline__ void xcd_barrier(const XcdBarrier& b) {
    asm volatile("s_waitcnt vmcnt(0)" ::: "memory");
    __syncthreads();
    if (threadIdx.x == 0) {
        unsigned* bar = b.bar;
        __builtin_amdgcn_s_waitcnt(0);
        unsigned nloc = b.st[0], nx = b.st[1];
        if (nloc == 0u) { xcd_barrier_complete(bar, b.x, nloc, nx); b.st[0] = nloc; b.st[1] = nx; }
        const unsigned old = xb_add(&bar[XB_XSUB(b.x)], 1u);
        const unsigned gen = old / nloc;
        if (old + 1u == (gen + 1u) * nloc) {
            __builtin_amdgcn_fence(__ATOMIC_RELEASE, "agent");
            asm volatile("s_waitcnt vmcnt(0)" ::: "memory");
            const unsigned og = xb_add(&bar[XB_TOP], 1u);
            const unsigned tg = og / nx;
            if (og + 1u == (tg + 1u) * nx) xb_add(&bar[XB_TOPGEN], 1u);
            else XB_SPIN(xb_ld(&bar[XB_TOPGEN]) == tg, bar);
            __builtin_amdgcn_fence(__ATOMIC_ACQUIRE, "agent");
            xb_add(&bar[XB_XGEN(b.x)], 1u);
            asm volatile("s_waitcnt vmcnt(0)" ::: "memory");
        } else {
            XB_SPIN(xb_ld(&bar[XB_XGEN(b.x)]) == gen, bar);
            __builtin_amdgcn_fence(__ATOMIC_ACQUIRE, "agent");
            asm volatile("s_waitcnt vmcnt(0)" ::: "memory");
        }
    }
    __syncthreads();
}

struct Args { const float* in[27]; float* out; unsigned char* ws; int ph_lo, ph_hi; };

__global__ void __launch_bounds__(512, 2) fwd_megakernel(Args a) {
    extern __shared__ __attribute__((aligned(16))) unsigned char lds_raw[];
    LAS unsigned char* lds = (LAS unsigned char*)lds_raw;
    cg::grid_group grid = cg::this_grid();
    const int tid = threadIdx.x, lane = tid & 63, wid = __builtin_amdgcn_readfirstlane(tid >> 6);
    const int G = gridDim.x, bx = blockIdx.x;
    const int vcu = (G % 8 == 0) ? (bx % 8) * (G / 8) + bx / 8 : bx;
    const int gw = vcu * 8 + wid, NGW = G * 8;
    unsigned char* ws = a.ws;
    const float* x = a.in[0];
    float* mod = (float*)(ws + WS_MOD); float* rss = (float*)(ws + WS_RSS); float* bias2 = (float*)(ws + WS_B2);
    bf16_t* Hb = (bf16_t*)(ws + WS_H);
    bf16_t *WinT = (bf16_t*)(ws + WS_WIN), *WgluT = (bf16_t*)(ws + WS_WGLU), *WoutT = (bf16_t*)(ws + WS_WOUT), *W1T = (bf16_t*)(ws + WS_W1), *W2T = (bf16_t*)(ws + WS_W2);
    bf16_t *UG = (bf16_t*)(ws + WS_UG), *Qb = (bf16_t*)(ws + WS_Q), *Kb = (bf16_t*)(ws + WS_K), *Vb = (bf16_t*)(ws + WS_V), *YS = (bf16_t*)(ws + WS_YS), *CAT = (bf16_t*)(ws + WS_CAT), *ACT = (bf16_t*)(ws + WS_ACT);
    float *AV = (float*)(ws + WS_AV), *A1K = (float*)(ws + WS_A1K); bf16_t *BB = (bf16_t*)(ws + WS_BB), *CM = (bf16_t*)(ws + WS_CM);
    const int lo = a.ph_lo, hi_ph = a.ph_hi;
#define IN(k) (lo <= (k) && (k) < hi_ph)
    volatile LAS unsigned* bst = (volatile LAS unsigned*)(lds + LDS_BYTES - 64);
    if (tid < 2) bst[tid] = 0u;
    __syncthreads();
    XcdBarrier xbar; xbar.bar = (unsigned*)(ws + WS_CTL); xbar.x = 0; xbar.st = bst;
    if (bx == 0) for (int i = tid; i < (int)(CTL_BYTES / 4); i += 512) ((unsigned*)(ws + WS_CTL))[i] = 0u;
#define SEAM(k) do { if (IN(k) && IN((k) + 1)) { if ((k) == 0) grid.sync(); else xcd_barrier(xbar); } } while (0)

    if (IN(0)) {
        LAS float* sl = (LAS float*)lds;
        LAS float* red = (LAS float*)(lds + 32768);
        if (bx < 192) {
            const float* cc = a.in[1];
            for (int i = tid; i < NB * DM; i += 512) { const float v = cc[i]; sl[i] = v / (1.0f + __expf(-v)); }
            __syncthreads();
            for (int it = bx; it < 192; it += G) {
                const float* wp = a.in[2] + (size_t)(wid * 256) * 12288 + it * 64 + lane;
                float ac[4] = {0.f, 0.f, 0.f, 0.f};
#pragma unroll 8
                for (int k = 0; k < 256; ++k) { const float w = __builtin_nontemporal_load(wp + (size_t)k * 12288); const int kk = wid * 256 + k;
                    ac[0] = fmaf(sl[kk], w, ac[0]); ac[1] = fmaf(sl[2048 + kk], w, ac[1]); ac[2] = fmaf(sl[4096 + kk], w, ac[2]); ac[3] = fmaf(sl[6144 + kk], w, ac[3]); }
#pragma unroll
                for (int b = 0; b < 4; ++b) red[(wid * 4 + b) * 64 + lane] = ac[b];
                __syncthreads();
                if (wid < 4) { float s = a.in[3][it * 64 + lane];
#pragma unroll
                    for (int w = 0; w < 8; ++w) s += red[(w * 4 + wid) * 64 + lane];
                    mod[(size_t)wid * 12288 + it * 64 + lane] = s; }
                __syncthreads();
            }
        }
        {
            LAS float* scr = (LAS float*)(lds + 40960 + wid * 8448);
            constexpr int I_IN = (DM / 64) * (INW / 32), I_GLU = (SSMW / 64) * (SSMW / 32), I_OUT = (DM / 64) * (DM / 32), I_1 = (DM / 64) * (HID / 32), I_2 = (HID / 64) * (DM / 32);
            constexpr int NITEMS = I_IN + I_GLU + I_OUT + I_1 + I_2;
            const int gw2 = ((vcu + 64) % G) * 8 + wid;
            for (int it = gw2; it < NITEMS; it += NGW) {
                int r = it;
                if (r < I_IN) { transpose_item(a.in[6], DM, INW, WinT, scr, r, lane); continue; } r -= I_IN;
                if (r < I_GLU) { transpose_item(a.in[15], SSMW, SSMW, WgluT, scr, r, lane); continue; } r -= I_GLU;
                if (r < I_OUT) { transpose_item(a.in[24], DM, DM, WoutT, scr, r, lane); continue; } r -= I_OUT;
                if (r < I_1) { transpose_item(a.in[25], DM, HID, W1T, scr, r, lane); continue; } r -= I_1;
                transpose_item(a.in[26], HID, DM, W2T, scr, r, lane);
            }
        }
        {
            const int gt = bx * 512 + tid;
            if (gt < NG * NP) {
                const int g = gt >> 6, p = gt & 63;
                const float dt = expf(a.in[14][g]), lr = a.in[7][gt], li = a.in[8][gt];
                const float mag = expf(dt * lr); float sn, cs; sincosf(dt * li, &sn, &cs);
                const float ar = mag * cs, ai = mag * sn, den = lr * lr + li * li, zr = ar - 1.0f;
                const float kr = (zr * lr + ai * li) / den, ki = (ai * lr - zr * li) / den;
                AV[gt * 2] = ar; AV[gt * 2 + 1] = ai;
                float pr = ar, pi = ai;
                for (int i = 0; i < 10; ++i) { const float nr = pr * pr - pi * pi, ni = 2.0f * pr * pi; pr = nr; pi = ni; }
                A1K[gt * 2] = pr; A1K[gt * 2 + 1] = pi;
                for (int h = 0; h < 16; ++h) { const float br = a.in[9][gt * 16 + h], bi = a.in[10][gt * 16 + h];
                    BB[(size_t)(g * 128 + p) * 16 + h] = f2bf(kr * br - ki * bi); BB[(size_t)(g * 128 + 64 + p) * 16 + h] = f2bf(kr * bi + ki * br); }
                for (int q = 0; q < 16; ++q) { CM[(size_t)(g * 16 + q) * 128 + 2 * p] = f2bf(a.in[11][(g * 16 + q) * 64 + p]); CM[(size_t)(g * 16 + q) * 128 + 2 * p + 1] = f2bf(-a.in[12][(g * 16 + q) * 64 + p]); }
            }
            for (int i = gt; i < MTOK; i += G * 512) rss[i] = 0.f;
        }
    }
    SEAM(0);
    if (lo == 0 && hi_ph > 1) xbar = xcd_barrier_post((unsigned*)(ws + WS_CTL), bst);
    if (IN(1)) {
        for (int m = gw; m < MTOK; m += NGW) { const int b = m >> 13;
            norm_row(x + (size_t)m * DM, Hb + (size_t)m * DM, a.in[4], mod + (size_t)b * 12288 + 2048, mod + (size_t)b * 12288, 0.f, false, lane); }
        for (int n = gw; n < HID; n += NGW) {
            const u32x4* wp = (const u32x4*)(W1T + (size_t)n * DM + lane * 32);
            float wv[32];
#pragma unroll
            for (int i = 0; i < 4; ++i) { const u32x4 w = wp[i]; wv[8 * i] = bflo(w.x); wv[8 * i + 1] = bfhi(w.x); wv[8 * i + 2] = bflo(w.y); wv[8 * i + 3] = bfhi(w.y);
                wv[8 * i + 4] = bflo(w.z); wv[8 * i + 5] = bfhi(w.z); wv[8 * i + 6] = bflo(w.w); wv[8 * i + 7] = bfhi(w.w); }
#pragma unroll
            for (int b = 0; b < NB; ++b) { const f32x4* sp = (const f32x4*)(mod + (size_t)b * 12288 + 3 * 2048 + lane * 32); float sacc = 0.f;
#pragma unroll
                for (int i = 0; i < 8; ++i) { const f32x4 sv = sp[i]; sacc += (sv[0] * wv[4 * i] + sv[1] * wv[4 * i + 1]) + (sv[2] * wv[4 * i + 2] + sv[3] * wv[4 * i + 3]); }
                sacc = wave_sum(sacc); if (lane == 0) bias2[(size_t)b * HID + n] = sacc; }
        }
    }
    SEAM(1);
    if (IN(2)) {
        pg8::Gemm g{Hb, WinT, MTOK, INW, DM}; pg8::StaticOrder S; S.init(MTOK, INW, G, bx, 4);
        EpiInProj E{UG, Qb, Kb, Vb, a.in[17], a.in[18]};
        pg8::gemm_phase<EpiInProj>(lds, g, S, E);
    }
    SEAM(2);
    if (IN(3)) {
        for (int it = vcu; it < NB * NG; it += G) ssm::item(it >> 6, it & 63, UG, YS, AV, A1K, BB, CM, a.in[13], (LAS char*)lds);
    }
    SEAM(3);
    if (IN(4)) {
        { pg8::Gemm g{YS, WgluT, MTOK, SSMW, SSMW}; pg8::StaticOrder S; S.init(MTOK, SSMW, G, bx, 4);
          EpiGlu E{YS, CAT, a.in[16]};
          pg8::gemm_phase<EpiGlu>(lds, g, S, E); }
        float lam;
        { const float p1 = lane < 64 ? a.in[19][lane] * a.in[20][lane] : 0.f, p2 = a.in[21][lane] * a.in[22][lane];
          lam = __expf(wave_sum(p1)) - __expf(wave_sum(p2)) + LAMBDA_INIT; }
        bool fastp;
        { float mq = fabsf(a.in[17][lane]), mk = fabsf(a.in[18][lane]);
#pragma unroll
          for (int o_ = 1; o_ < 64; o_ <<= 1) { mq = fmaxf(mq, __shfl_xor(mq, o_)); mk = fmaxf(mk, __shfl_xor(mk, o_)); }
          fastp = (64.0f * QSCALE * mq * mk * 1.05f) < 60.0f; }
        { const int nu = (G == 256) ? 8 : (2048 - vcu + G - 1) / G;
          for (int i = 0; i < nu; ++i) { int bh, qb;
              if (G == 256) { const int j = vcu & 31; bh = (vcu >> 5) * 4 + (i >> 1); qb = (i & 1) ? j : 63 - j; }
              else { const int u = vcu + i * G; bh = u >> 6; qb = 63 - (u & 63); }
              if (fastp) att::unit<true>(bh >> 3, bh & 7, qb, Qb, Kb, Vb, CAT, (LAS char*)lds, lam, a.in[23]);
              else att::unit<false>(bh >> 3, bh & 7, qb, Qb, Kb, Vb, CAT, (LAS char*)lds, lam, a.in[23]); } }
    }
    SEAM(4);
    if (IN(5)) {
        pg8::Gemm g{CAT, WoutT, MTOK, DM, DM}; pg8::StaticOrder S; S.init(MTOK, DM, G, bx, 8);
        EpiResid<true> E{x, a.out, mod + 4096, rss, a.in[5], mod + 4 * 2048, Hb, (bf16_t*)(ws + WS_X1B)};
        pg8::gemm_phase<EpiResid<true>>(lds, g, S, E);
    }
    SEAM(5);
    if (IN(7)) {
        pg8::Gemm g{Hb, W1T, MTOK, HID, DM}; pg8::StaticOrder S; S.init(MTOK, HID, G, bx, 4);
        EpiMlp1 E{ACT, rss, bias2};
        pg8::gemm_phase<EpiMlp1>(lds, g, S, E);
    }
    SEAM(7);
    if (IN(8)) {
        pg8::Gemm g{ACT, W2T, MTOK, DM, HID}; pg8::StaticOrder S; S.init(MTOK, DM, G, bx, 8);
        EpiResid<false> E{nullptr, a.out, mod + 5 * 2048, nullptr, nullptr, nullptr, nullptr, (bf16_t*)(ws + WS_X1B)};
        pg8::gemm_phase<EpiResid<false>>(lds, g, S, E);
    }
#undef IN
#undef SEAM
}

#ifndef MK_PER_PHASE
#define MK_PER_PHASE 0
#endif
extern "C" void kernel_launch(void* const* d_in, const int* in_sizes, int n_in, void* d_out, int out_size, void* d_ws, size_t ws_size, hipStream_t stream) {
    static int grid = 0;
    if (grid == 0) {
        if (n_in != 27 || out_size != MTOK * DM || ws_size < WS_END) { fprintf(stderr, "kernel_launch: unexpected shapes (n_in %d out %d ws %zu)\n", n_in, out_size, ws_size); grid = -1; return; }
        int dev = 0, cus = 0, per_cu = 0;
        hipGetDevice(&dev); hipDeviceGetAttribute(&cus, hipDeviceAttributeMultiprocessorCount, dev);
        if (hipFuncSetAttribute((const void*)fwd_megakernel, hipFuncAttributeMaxDynamicSharedMemorySize, LDS_BYTES) != hipSuccess) { fprintf(stderr, "kernel_launch: hipFuncSetAttribute failed\n"); grid = -1; return; }
        hipOccupancyMaxActiveBlocksPerMultiprocessor(&per_cu, (const void*)fwd_megakernel, 512, LDS_BYTES);
        (void)hipGetLastError();
        if (per_cu < 1) per_cu = 1;
        grid = cus;
        fprintf(stderr, "kernel_launch: cus %d per_cu %d grid %d\n", cus, per_cu, grid);
    }
    if (grid < 0) return;
    Args a{};
    for (int i = 0; i < 27; ++i) a.in[i] = (const float*)d_in[i];
    a.out = (float*)d_out; a.ws = (unsigned char*)d_ws;
#if MK_PER_PHASE
    for (int p = 0; p < 9; ++p) { a.ph_lo = p; a.ph_hi = p + 1; void* args[] = {&a};
        hipError_t e = hipLaunchCooperativeKernel((const void*)fwd_megakernel, dim3(grid), dim3(512), args, LDS_BYTES, stream);
        if (e != hipSuccess) fprintf(stderr, "launch %d failed: %s\n", p, hipGetErrorString(e)); }
#else
    a.ph_lo = 0; a.ph_hi = 9; void* args[] = {&a};
    hipError_t e = hipLaunchCooperativeKernel((const void*)fwd_megakernel, dim3(grid), dim3(512), args, LDS_BYTES, stream);
    if (e != hipSuccess) fprintf(stderr, "cooperative launch failed: %s (grid %d)\n", hipGetErrorString(e), grid);
#endif
}
```
